# Optimizing an MI355X kernel written in HIP

```python
import math
import jax, jax.numpy as jnp
from jax import lax
import numpy as np

D_MODEL = 1024
BATCH = 2
SEQ = 8192
DEPTH = 1
DEC_BATCH = 128
DEC_SEQ = 4
PAST_LEN = 2048
PAGE_SIZE = 128

MIX_WIDTH = D_MODEL
DIFF_WIDTH = MIX_WIDTH // 2
RET_WIDTH = MIX_WIDTH - DIFF_WIDTH
DIFF_V_DIM = 128
N_DIFF_HEADS = DIFF_WIDTH // DIFF_V_DIM
DIFF_QK_DIM = DIFF_V_DIM // 2
ROT_DIM = DIFF_QK_DIM // 4
ROPE_THETA = 500000.0
RET_V_DIM = 128
N_RET_HEADS = RET_WIDTH // RET_V_DIM
RET_QK_DIM = RET_V_DIM // 2
RET_THETA = 10000.0
RET_CHUNK = 128
Q_BLOCK = 128
D_FF = -(-8 * D_MODEL // (3 * 256)) * 256
NORM_EPS = 1e-6
SUBLN_EPS = 1e-5

SPLIT_SIZES = (
    N_DIFF_HEADS * 2 * DIFF_QK_DIM,
    N_DIFF_HEADS * 2 * DIFF_QK_DIM,
    N_DIFF_HEADS * DIFF_V_DIM,
    N_RET_HEADS * RET_QK_DIM,
    N_RET_HEADS * RET_QK_DIM,
    N_RET_HEADS * RET_V_DIM,
    RET_WIDTH,
)
IN_WIDTH = sum(SPLIT_SIZES)
SPLIT_POINTS = tuple(int(s) for s in np.cumsum(SPLIT_SIZES)[:-1])

kernel_name = 'hymba_diffattn_retnet_step'


def rms_norm(x, g, eps):
    xf = x.astype(jnp.float32)
    y = xf * lax.rsqrt(jnp.mean(xf * xf, axis=-1, keepdims=True) + eps)
    if g is not None:
        y = y * g.astype(jnp.float32)
    return y.astype(x.dtype)


def rope_table(pos, dim, theta):
    inv = 1.0 / (jnp.float32(theta) ** (jnp.arange(0, dim, 2, dtype=jnp.float32) / dim))
    ang = pos.astype(jnp.float32)[:, None] * inv[None, :]
    return jnp.cos(ang), jnp.sin(ang)


def rotate(x, cos, sin):
    xf = x.astype(jnp.float32)
    x1, x2 = jnp.split(xf, 2, axis=-1)
    return jnp.concatenate([x1 * cos - x2 * sin, x2 * cos + x1 * sin], axis=-1).astype(x.dtype)


def partial_rotary(x, cos, sin):
    return jnp.concatenate([rotate(x[..., :ROT_DIM], cos, sin), x[..., ROT_DIM:]], axis=-1)


def project_mixer_inputs(h, w_in_l, cos_d, sin_d, cos_r, sin_r):
    B, T, _ = h.shape
    z = h @ w_in_l
    dq, dk, dv, rq, rk, rv, rg = jnp.split(z, SPLIT_POINTS, axis=-1)
    dq = partial_rotary(dq.reshape(B, T, N_DIFF_HEADS, 2, DIFF_QK_DIM), cos_d, sin_d) * DIFF_QK_DIM ** -0.5
    dk = partial_rotary(dk.reshape(B, T, N_DIFF_HEADS, 2, DIFF_QK_DIM), cos_d, sin_d)
    dv = dv.reshape(B, T, N_DIFF_HEADS, DIFF_V_DIM)
    rq = rotate(rq.reshape(B, T, N_RET_HEADS, RET_QK_DIM), cos_r, sin_r)
    rk = rotate(rk.reshape(B, T, N_RET_HEADS, RET_QK_DIM), cos_r, sin_r) * RET_QK_DIM ** -0.5
    rv = rv.reshape(B, T, N_RET_HEADS, RET_V_DIM)
    return dq, dk, dv, rq, rk, rv, rg


def diff_attend(q, k, v, mask, lam):
    s = jnp.einsum('bqhmd,bkhmd->bhmqk', q, k).astype(jnp.float32)
    s = jnp.where(mask, s, -1e30)
    p = jax.nn.softmax(s, axis=-1)
    a = p[:, :, 0] - lam * p[:, :, 1]
    return jnp.einsum('bhqk,bkhe->bqhe', a.astype(v.dtype), v)


def prompt_diff_attention(q, k, v, lam):
    B, S = q.shape[:2]
    n_blk = S // Q_BLOCK
    qb = q.reshape(B, n_blk, Q_BLOCK, *q.shape[2:]).swapaxes(0, 1)
    kpos = jnp.arange(S)

    def one_block(args):
        q_blk, i = args
        qpos = i * Q_BLOCK + jnp.arange(Q_BLOCK)
        return diff_attend(q_blk, k, v, kpos[None, :] <= qpos[:, None], lam)

    out = lax.map(one_block, (qb, jnp.arange(n_blk)))
    return out.swapaxes(0, 1).reshape(B, S, *out.shape[3:])


def retention_chunk(q, k, v, state, log_gamma):
    C = q.shape[1]
    qf, kf, vf = (t.astype(jnp.float32) for t in (q, k, v))
    st = state.astype(jnp.float32)
    idx = jnp.arange(C, dtype=jnp.float32)
    rel = idx[:, None] - idx[None, :]
    decay = jnp.where(rel >= 0, jnp.exp(log_gamma[:, None, None] * jnp.maximum(rel, 0.0)), 0.0)
    scores = jnp.einsum('bihd,bjhd->bhij', qf, kf) * decay
    inner = jnp.einsum('bhij,bjhe->bihe', scores, vf)
    q_decay = jnp.exp(log_gamma[None, :] * (idx[:, None] + 1.0))
    cross = jnp.einsum('bihd,bhde->bihe', qf, st) * q_decay[None, :, :, None]
    k_decay = jnp.exp(log_gamma[None, :] * (C - 1.0 - idx[:, None]))
    new_state = (jnp.exp(log_gamma * C)[None, :, None, None] * st
                 + jnp.einsum('bjhd,bjhe->bhde', kf * k_decay[None, :, :, None], vf))
    return inner + cross, new_state


def prompt_retention(q, k, v, log_gamma):
    B, S, H, dk = q.shape
    dv = v.shape[-1]
    n_chunks = S // RET_CHUNK

    def chunks(t):
        return t.reshape(B, n_chunks, RET_CHUNK, *t.shape[2:]).swapaxes(0, 1)

    def step(state, qkv):
        out, state = retention_chunk(*qkv, state, log_gamma)
        return state, out

    state0 = jnp.zeros((B, H, dk, dv), jnp.float32)
    state, out = lax.scan(step, state0, (chunks(q), chunks(k), chunks(v)))
    return out.swapaxes(0, 1).reshape(B, S, H, dv), state


def merge_head_groups(diff_o, ret_o, ret_gate, subln_g, lam_init, w_out_l):
    B, T = diff_o.shape[:2]
    d = rms_norm(diff_o, subln_g, SUBLN_EPS) * (1.0 - lam_init)
    r = rms_norm(ret_o, None, NORM_EPS).reshape(B, T, RET_WIDTH).astype(ret_gate.dtype)
    r = jax.nn.silu(ret_gate) * r
    cat = jnp.concatenate([d.reshape(B, T, DIFF_WIDTH).astype(r.dtype), r], axis=-1)
    return cat @ w_out_l


def swiglu(h, w_in_l, w_out_l):
    g, u = jnp.split(h @ w_in_l, 2, axis=-1)
    return (jax.nn.silu(g) * u) @ w_out_l


def setup_inputs(seed: int = 0) -> dict:
    key = jax.random.key(seed)
    ks = jax.random.split(key, 16)
    n_pages = PAST_LEN // PAGE_SIZE
    n_used = DEC_BATCH * n_pages
    n_phys = n_used + max(1, n_used // 4)

    def normal(k, shape, scale):
        return jax.random.normal(k, shape, jnp.float32) * scale

    page_table = jax.random.permutation(ks[0], n_phys)[:n_used].reshape(DEC_BATCH, n_pages).astype(jnp.int32)
    return {
        'x_prompt': normal(ks[1], (BATCH, SEQ, D_MODEL), 1.0),
        'x_sample': normal(ks[2], (DEC_BATCH, DEC_SEQ, D_MODEL), 1.0),
        'cache_diff_k': normal(ks[3], (DEPTH, n_phys, PAGE_SIZE, N_DIFF_HEADS, 2, DIFF_QK_DIM), 1.0),
        'cache_diff_v': normal(ks[4], (DEPTH, n_phys, PAGE_SIZE, N_DIFF_HEADS, DIFF_V_DIM), 1.0),
        'state_ret': normal(ks[5], (DEPTH, DEC_BATCH, N_RET_HEADS, RET_QK_DIM, RET_V_DIM), 0.5),
        'page_table': page_table,
        'norm_mix_g': 1.0 + normal(ks[6], (DEPTH, D_MODEL), 0.02),
        'w_in': normal(ks[7], (DEPTH, D_MODEL, IN_WIDTH), D_MODEL ** -0.5),
        'diff_lambda': normal(ks[8], (DEPTH, 4, DIFF_QK_DIM), 0.1),
        'diff_subln_g': 1.0 + normal(ks[9], (DEPTH, DIFF_V_DIM), 0.02),
        'w_out': normal(ks[10], (DEPTH, MIX_WIDTH, D_MODEL), MIX_WIDTH ** -0.5),
        'norm_ffn_g': 1.0 + normal(ks[11], (DEPTH, D_MODEL), 0.02),
        'w_ffn_in': normal(ks[12], (DEPTH, D_MODEL, 2 * D_FF), D_MODEL ** -0.5),
        'w_ffn_out': normal(ks[13], (DEPTH, D_FF, D_MODEL), D_FF ** -0.5),
        'norm_final_g': 1.0 + normal(ks[14], (D_MODEL,), 0.02),
    }


def reference(x_prompt, x_sample, cache_diff_k, cache_diff_v, state_ret, page_table,
              norm_mix_g, w_in, diff_lambda, diff_subln_g, w_out, norm_ffn_g,
              w_ffn_in, w_ffn_out, norm_final_g):
    S = x_prompt.shape[1]
    DB, T = x_sample.shape[:2]
    past = page_table.shape[1] * cache_diff_k.shape[2]
    pos_p = jnp.arange(S)
    pos_s = past + jnp.arange(T)

    def tables(pos):
        cd, sd = rope_table(pos, ROT_DIM, ROPE_THETA)
        cr, sr = rope_table(pos, RET_QK_DIM, RET_THETA)
        return cd[:, None, None, :], sd[:, None, None, :], cr[:, None, :], sr[:, None, :]

    tab_p = tables(pos_p)
    tab_s = tables(pos_s)
    mask_s = jnp.arange(past + T)[None, :] <= pos_s[:, None]
    log_gamma = jnp.log(1.0 - 2.0 ** (-5.0 - jnp.arange(N_RET_HEADS, dtype=jnp.float32)))

    xp, xs = x_prompt, x_sample
    k_p, v_p, r_p, k_s, v_s, r_s = [], [], [], [], [], []
    for l in range(DEPTH):
        lam_init = 0.8 - 0.6 * math.exp(-0.3 * l)
        lp = diff_lambda[l].astype(jnp.float32)
        lam = jnp.exp(jnp.sum(lp[0] * lp[1])) - jnp.exp(jnp.sum(lp[2] * lp[3])) + lam_init

        hp = rms_norm(xp, norm_mix_g[l], NORM_EPS)
        dq, dk, dv, rq, rk, rv, rg = project_mixer_inputs(hp, w_in[l], *tab_p)
        diff_o = prompt_diff_attention(dq, dk, dv, lam)
        ret_o, ret_state_p = prompt_retention(rq, rk, rv, log_gamma)
        xp = xp + merge_head_groups(diff_o, ret_o, rg, diff_subln_g[l], lam_init, w_out[l])
        xp = xp + swiglu(rms_norm(xp, norm_ffn_g[l], NORM_EPS), w_ffn_in[l], w_ffn_out[l])
        k_p.append(dk)
        v_p.append(dv)
        r_p.append(ret_state_p.astype(xp.dtype))

        hs = rms_norm(xs, norm_mix_g[l], NORM_EPS)
        sq, sk, sv, tq, tk, tv, tg = project_mixer_inputs(hs, w_in[l], *tab_s)
        k_past = cache_diff_k[l][page_table].reshape(DB, past, N_DIFF_HEADS, 2, DIFF_QK_DIM)
        v_past = cache_diff_v[l][page_table].reshape(DB, past, N_DIFF_HEADS, DIFF_V_DIM)
        k_all = jnp.concatenate([k_past.astype(sk.dtype), sk], axis=1)
        v_all = jnp.concatenate([v_past.astype(sv.dtype), sv], axis=1)
        diff_os = diff_attend(sq, k_all, v_all, mask_s, lam)
        ret_os, ret_state_s = retention_chunk(tq, tk, tv, state_ret[l], log_gamma)
        xs = xs + merge_head_groups(diff_os, ret_os, tg, diff_subln_g[l], lam_init, w_out[l])
        xs = xs + swiglu(rms_norm(xs, norm_ffn_g[l], NORM_EPS), w_ffn_in[l], w_ffn_out[l])
        k_s.append(sk)
        v_s.append(sv)
        r_s.append(ret_state_s.astype(xs.dtype))

    y_prompt = rms_norm(xp, norm_final_g, NORM_EPS)
    y_sample = rms_norm(xs, norm_final_g, NORM_EPS)
    k_prompt = jnp.stack(k_p)
    v_prompt = jnp.stack(v_p)
    ret_prompt = jnp.stack(r_p)
    k_sample = jnp.stack(k_s)
    v_sample = jnp.stack(v_s)
    ret_sample = jnp.stack(r_s)
    return (y_prompt, y_sample, k_prompt, v_prompt, ret_prompt, k_sample, v_sample, ret_sample)
```

```cpp
#include <hip/hip_runtime.h>
#include <cstdio>
#include <cstdint>
#ifndef PH_HI
#define PH_HI 9
#endif
namespace pg8 {
#define PG8_LAS __attribute__((address_space(3)))
typedef unsigned short bf16_t;
typedef short bf16x8 __attribute__((ext_vector_type(8)));
typedef float f32x4 __attribute__((ext_vector_type(4)));
typedef unsigned u32x4 __attribute__((ext_vector_type(4)));
constexpr int BM = 256, BK = 64, HALF = 128, HTB = HALF * BK * 2  , STAGE_BYTES = 8 * HTB, NXCD = 8, WGM = 8;

__host__ __device__ __forceinline__ int lds_byte(int r, int c) { const int st = (r >> 4) * 2 + (c >> 5), rr = r & 15, cc = c & 31, ob = rr * 64 + cc * 2; return st * 1024 + (ob ^ (((ob >> 9) & 1) << 5)); }
__host__ __device__ __forceinline__ void stage_rc(int b, int& R, int& C) { const int st = b / 1024, sb = b % 1024, swz = sb ^ (((sb >> 9) & 1) << 5); R = (st >> 1) * 16 + swz / 64; C = (st & 1) * 32 + (swz % 64) / 2; }
__host__ __device__ __forceinline__ int perm32(int rho) { const int n = rho >> 4, i = rho & 15; return 8 * (i >> 2) + 4 * n + (i & 3); }

struct Unit { int pm, pn; };
struct Gemm { const bf16_t* A; const bf16_t* Bt; int M, N, K; };

struct StaticOrder {
    int nM, nN, nwg, G, c;
    __host__ __device__ void init(int M, int N, int G_, int c_) { nM = M / BM; nN = N / BM; nwg = nM * nN; G = G_; c = c_; }
    __host__ __device__ bool next(int i, Unit& u) const {
        const long L = (long)i * G + c; if (L >= nwg) return false;
        int wgid = (int)L; { const int q = nwg / NXCD, r = nwg % NXCD, xcd = wgid % NXCD, off = wgid / NXCD; wgid = (xcd < r ? xcd * (q + 1) : r * (q + 1) + (xcd - r) * q) + off; }
        const int nig = WGM * nN, gid = wgid / nig, fm = gid * WGM, gsz = (nM - fm) < WGM ? (nM - fm) : WGM;
        u.pm = fm + ((wgid % nig) % gsz); u.pn = (wgid % nig) / gsz; return true;
    }
    __device__ __forceinline__ void a_ready(const Unit&) const {}
    __device__ __forceinline__ void done(const Unit&) const {}
};

__device__ __forceinline__ unsigned cvt_pk_bf16(float lo, float hi) { unsigned r; asm volatile("v_cvt_pk_bf16_f32 %0, %1, %2" : "=v"(r) : "v"(lo), "v"(hi)); return r; }
typedef float f32x2 __attribute__((ext_vector_type(2)));
typedef unsigned u32x2 __attribute__((ext_vector_type(2)));
constexpr int MP = 16384, MS = 512, MT = MP + MS;
constexpr long OFF_Y = 0, OFF_KP = 17301504, OFF_VP = 25690112, OFF_RP = 34078720, OFF_KS = 34144256, OFF_VS = 34406400, OFF_RS = 34668544;
__device__ __forceinline__ void st4bf(bf16_t* p, f32x4 v) { u32x2 w; w.x = cvt_pk_bf16(v[0], v[1]); w.y = cvt_pk_bf16(v[2], v[3]); *(u32x2*)p = w; }
__device__ __forceinline__ void st8bf(bf16_t* p, f32x4 a, f32x4 b) { u32x4 w; w.x = cvt_pk_bf16(a[0], a[1]); w.y = cvt_pk_bf16(a[2], a[3]); w.z = cvt_pk_bf16(b[0], b[1]); w.w = cvt_pk_bf16(b[2], b[3]); *(u32x4*)p = w; }
__device__ __forceinline__ float silu1(float x) { return x * __builtin_amdgcn_rcpf(1.f + __builtin_amdgcn_exp2f(-1.4426950408889634f * x)); }
__device__ __forceinline__ f32x4 silu4(f32x4 v) { return (f32x4){silu1(v[0]), silu1(v[1]), silu1(v[2]), silu1(v[3])}; }

struct EpiInProj {
    static constexpr bool PERM = true, AFTER_DRAIN = false;
    bf16_t *DQ, *DK, *DV, *RQ, *RK, *RV, *RG; float* out; const float *cosd, *sind, *cosr, *sinr;
    __device__ __forceinline__ void operator()(const f32x4 (&acc)[2][2][4][2], const Unit& u, int wr, int wc, int fr, int fq) const {
        const int pn = u.pn, rowt = u.pm * BM + wr * 64 + fr, colt = wc * 32 + 8 * fq;
        const bool smp = u.pm >= MP / BM;
        float* kout = smp ? out + OFF_KS - (long)MP * 512 : out + OFF_KP;
        float* vout = smp ? out + OFF_VS - (long)MP * 512 : out + OFF_VP;
#pragma unroll
        for (int ai = 0; ai < 2; ++ai)
#pragma unroll
            for (int m = 0; m < 4; ++m) {
                const int row = rowt + ai * HALF + m * 16;
                const int pos = smp ? 2048 + ((row - MP) & 3) : (row & 8191);
#pragma unroll
                for (int bj = 0; bj < 2; ++bj) {
                    const int gc = pn * 256 + bj * 128 + colt;
                    const f32x4 v0 = acc[ai][bj][m][0], v1 = acc[ai][bj][m][1];
                    if (pn < 4) {
                        const int lc = gc & 511, d8 = lc & 63; const bool isk = pn >= 2;
                        bf16_t* dst = (isk ? DK : DQ) + (size_t)row * 512;
                        if (d8 < 16) {
                            const int i0 = (d8 >> 3) * 4, c1 = (lc & ~63) + i0, c2 = c1 + 8;
                            const f32x4 cs = *(const f32x4*)(cosd + pos * 8 + i0), sn = *(const f32x4*)(sind + pos * 8 + i0);
                            const f32x4 o1 = v0 * cs - v1 * sn, o2 = v1 * cs + v0 * sn;
                            st4bf(dst + c1, o1); st4bf(dst + c2, o2);
                            if (isk) { *(f32x4*)(kout + (size_t)row * 512 + c1) = o1; *(f32x4*)(kout + (size_t)row * 512 + c2) = o2; }
                        } else {
                            st8bf(dst + lc, v0, v1);
                            if (isk) { *(f32x4*)(kout + (size_t)row * 512 + lc) = v0; *(f32x4*)(kout + (size_t)row * 512 + lc + 4) = v1; }
                        }
                    } else if (pn < 6) {
                        const int lc = gc - 1024;
                        st8bf(DV + (size_t)row * 512 + lc, v0, v1);
                        *(f32x4*)(vout + (size_t)row * 512 + lc) = v0; *(f32x4*)(vout + (size_t)row * 512 + lc + 4) = v1;
                    } else if (pn < 8) {
                        const int lc = gc - (pn == 6 ? 1536 : 1792), d8 = lc & 63, i0 = (d8 >> 3) * 4, c1 = (lc & ~63) + i0, c2 = c1 + 32;
                        const f32x4 cs = *(const f32x4*)(cosr + pos * 32 + i0), sn = *(const f32x4*)(sinr + pos * 32 + i0);
                        f32x4 o1 = v0 * cs - v1 * sn, o2 = v1 * cs + v0 * sn;
                        bf16_t* dst = (pn == 6 ? RQ : RK) + (size_t)row * 256;
                        if (pn == 7) { o1 = o1 * 0.125f; o2 = o2 * 0.125f; }
                        st4bf(dst + c1, o1); st4bf(dst + c2, o2);
                    } else if (pn < 10) {
                        st8bf(RV + (size_t)row * 512 + (gc - 2048), v0, v1);
                    } else {
                        st8bf(RG + (size_t)row * 512 + (gc - 2560), silu4(v0), silu4(v1));
                    }
                }
            }
    }
};
struct EpiOutProj {
    static constexpr bool PERM = true, AFTER_DRAIN = false;
    const float* xp; const float* xs; float* X1; bf16_t* X1B; float* SSQ;
    __device__ __forceinline__ void operator()(const f32x4 (&acc)[2][2][4][2], const Unit& u, int wr, int wc, int fr, int fq) const {
        const int rowt = u.pm * BM + wr * 64 + fr, colt = u.pn * BM + wc * 32 + 8 * fq;
        const float* xb = (u.pm >= MP / BM) ? xs - (long)MP * 1024 : xp;
#pragma unroll
        for (int ai = 0; ai < 2; ++ai)
#pragma unroll
            for (int m = 0; m < 4; ++m) {
                const int row = rowt + ai * HALF + m * 16; float ss = 0.f;
#pragma unroll
                for (int bj = 0; bj < 2; ++bj) {
                    const size_t off = (size_t)row * 1024 + colt + bj * HALF;
                    const f32x4 v0 = acc[ai][bj][m][0] + *(const f32x4*)(xb + off), v1 = acc[ai][bj][m][1] + *(const f32x4*)(xb + off + 4);
                    *(f32x4*)(X1 + off) = v0; *(f32x4*)(X1 + off + 4) = v1; st8bf(X1B + off, v0, v1);
                    ss += (v0[0] * v0[0] + v0[1] * v0[1]) + (v0[2] * v0[2] + v0[3] * v0[3]) + (v1[0] * v1[0] + v1[1] * v1[1]) + (v1[2] * v1[2] + v1[3] * v1[3]);
                }
                ss += __shfl_xor(ss, 16); ss += __shfl_xor(ss, 32);
                if (fq == 0) SSQ[(size_t)row * 16 + u.pn * 4 + wc] = ss;
            }
    }
};
struct EpiUp {
    static constexpr bool PERM = true, AFTER_DRAIN = false;
    bf16_t* H; const float* SSQ;
    __device__ __forceinline__ void operator()(const f32x4 (&acc)[2][2][4][2], const Unit& u, int wr, int wc, int fr, int fq) const {
        const int rowt = u.pm * BM + wr * 64 + fr, colt = u.pn * BM + wc * 32 + 8 * fq;
#pragma unroll
        for (int ai = 0; ai < 2; ++ai)
#pragma unroll
            for (int m = 0; m < 4; ++m) {
                const int row = rowt + ai * HALF + m * 16;
                const f32x4* sp = (const f32x4*)(SSQ + (size_t)row * 16);
                const f32x4 s0 = sp[0], s1 = sp[1], s2 = sp[2], s3 = sp[3];
                const float tot = ((s0[0] + s0[1]) + (s0[2] + s0[3])) + ((s1[0] + s1[1]) + (s1[2] + s1[3])) + ((s2[0] + s2[1]) + (s2[2] + s2[3])) + ((s3[0] + s3[1]) + (s3[2] + s3[3]));
                const float r = 1.0f / sqrtf(tot * (1.0f / 1024.0f) + 1e-6f);
#pragma unroll
                for (int bj = 0; bj < 2; ++bj) {
                    const int f0 = (colt + bj * HALF) >> 1;
                    const f32x4 g = acc[ai][bj][m][0] * r, uu = acc[ai][bj][m][1] * r;
                    st4bf(H + (size_t)row * 2816 + f0, silu4(g) * uu);
                }
            }
    }
};
struct EpiDown {
    static constexpr bool PERM = true, AFTER_DRAIN = false;
    const float* X1; float* Y;
    __device__ __forceinline__ void operator()(const f32x4 (&acc)[2][2][4][2], const Unit& u, int wr, int wc, int fr, int fq) const {
        const int rowt = u.pm * BM + wr * 64 + fr, colt = u.pn * BM + wc * 32 + 8 * fq;
#pragma unroll
        for (int ai = 0; ai < 2; ++ai)
#pragma unroll
            for (int m = 0; m < 4; ++m) {
                const int row = rowt + ai * HALF + m * 16;
#pragma unroll
                for (int bj = 0; bj < 2; ++bj) {
                    const size_t off = (size_t)row * 1024 + colt + bj * HALF;
                    *(f32x4*)(Y + off) = acc[ai][bj][m][0] + *(const f32x4*)(X1 + off); *(f32x4*)(Y + off + 4) = acc[ai][bj][m][1] + *(const f32x4*)(X1 + off + 4);
                }
            }
    }
};
template <class Epi, class Sched, bool ALIGN_EPI = false, bool SP2 = false>
__device__ __forceinline__ void gemm_phase(PG8_LAS unsigned char* lds, const Gemm g, const Sched& S, const Epi& E) {
    int tid_l = threadIdx.x; asm volatile("" : "+v"(tid_l));
    const int tid = tid_l, wid = __builtin_amdgcn_readfirstlane(tid >> 6), lane = tid & 63, wr = wid >> 2, wc = wid & 3, fr = lane & 15, fq = lane >> 4;
    const int K = g.K, nt = K / BK;
    unsigned voffA[2], voffB[2];
#pragma unroll
    for (int i = 0; i < 2; ++i) { int R, C; stage_rc(tid * 16 + i * 8192, R, C); const int Rb = Epi::PERM ? ((R & ~31) + perm32(R & 31)) : R;
        voffA[i] = (unsigned)(R * K + C) * 2u; voffB[i] = (unsigned)(Rb * K + C) * 2u; }
    const size_t kstep = (size_t)(BK * 2);
    const size_t hstep = (size_t)HALF * K * 2;
    const size_t tstep = 2 * hstep;
    const unsigned ldsw = (unsigned)wid * 1024u;
    const int aoff = lds_byte(wr * 64 + fr, fq * 8), boff = lds_byte(wc * 32 + fr, fq * 8);
#define PG8_SA(b, h) (((b) * 2 + (h)) * HTB)
#define PG8_SB(b, h) ((4 + (b) * 2 + (h)) * HTB)
#define PG8_STAGE(bufoff, gbase, voff) do { _Pragma("unroll") for (int _i = 0; _i < 2; ++_i) \
        __builtin_amdgcn_global_load_lds((const unsigned*)((const char*)(gbase) + (voff)[_i]), (PG8_LAS unsigned*)(lds + (bufoff) + ldsw + _i * 8192), 16, 0, 0); } while (0)
#define PG8_LDA(dst, b, h) do { _Pragma("unroll") for (int m = 0; m < 4; ++m) _Pragma("unroll") for (int k = 0; k < 2; ++k) dst[m][k] = *(const PG8_LAS bf16x8*)(lds + PG8_SA(b, h) + aoff + m * 2048 + k * 1024); } while (0)
#define PG8_LDB(dst, b, h) do { _Pragma("unroll") for (int n = 0; n < 2; ++n) _Pragma("unroll") for (int k = 0; k < 2; ++k) dst[n][k] = *(const PG8_LAS bf16x8*)(lds + PG8_SB(b, h) + boff + n * 2048 + k * 1024); } while (0)
#define PG8_MMA(ai, bj, At, Bt) do { __builtin_amdgcn_s_setprio(1); _Pragma("unroll") for (int m = 0; m < 4; ++m) _Pragma("unroll") for (int n = 0; n < 2; ++n) _Pragma("unroll") for (int k = 0; k < 2; ++k) \
        acc[ai][bj][m][n] = __builtin_amdgcn_mfma_f32_16x16x32_bf16(Bt[n][k], At[m][k], acc[ai][bj][m][n], 0, 0, 0); __builtin_amdgcn_s_setprio(0); } while (0)
#define PG8_WAIT_V(n) asm volatile("s_waitcnt vmcnt(" #n ")" ::: "memory")
#define PG8_WAIT_L(n) asm volatile("s_waitcnt lgkmcnt(" #n ")" ::: "memory")
#define PG8_BAR __builtin_amdgcn_s_barrier()
#define PG8_SCHED __builtin_amdgcn_sched_barrier(0)
    Unit cur, nxt; int ui = 0;
    if (!S.next(0, cur)) return;
    f32x4 acc[2][2][4][2];
#pragma unroll
    for (int a = 0; a < 2; ++a)
#pragma unroll
        for (int b = 0; b < 2; ++b)
#pragma unroll
            for (int m = 0; m < 4; ++m)
#pragma unroll
                for (int n = 0; n < 2; ++n) acc[a][b][m][n] = (f32x4){0.f, 0.f, 0.f, 0.f};
    bf16x8 At[4][2], B0[2][2], B1[2][2];
    const char* cA = (const char*)g.A + (size_t)cur.pm * tstep; const char* cB = (const char*)g.Bt + (size_t)cur.pn * tstep;
    S.a_ready(cur);
    if constexpr (SP2) {
        PG8_STAGE(PG8_SB(0, 0), cB, voffB); PG8_STAGE(PG8_SB(0, 1), cB + hstep, voffB); PG8_STAGE(PG8_SA(0, 0), cA, voffA); PG8_STAGE(PG8_SA(0, 1), cA + hstep, voffA);
        if (wr == 1) PG8_BAR;
        PG8_WAIT_V(2); PG8_BAR;
        PG8_STAGE(PG8_SB(1, 0), cB + kstep, voffB); PG8_STAGE(PG8_SA(1, 0), cA + kstep, voffA); PG8_STAGE(PG8_SB(1, 1), cB + hstep + kstep, voffB);
        PG8_WAIT_V(6); PG8_BAR;
    } else {
        PG8_STAGE(PG8_SB(0, 0), cB, voffB); PG8_STAGE(PG8_SA(0, 0), cA, voffA); PG8_STAGE(PG8_SB(0, 1), cB + hstep, voffB); PG8_STAGE(PG8_SA(0, 1), cA + hstep, voffA);
        if (wr == 1) PG8_BAR;
        PG8_WAIT_V(4); PG8_BAR;
        PG8_STAGE(PG8_SB(1, 0), cB + kstep, voffB); PG8_STAGE(PG8_SA(1, 0), cA + kstep, voffA); PG8_STAGE(PG8_SB(1, 1), cB + hstep + kstep, voffB);
        PG8_WAIT_V(6); PG8_BAR;
    }
    for (;;) {
        const bool has_next = S.next(ui + 1, nxt);
        const char* nA = has_next ? (const char*)g.A + (size_t)nxt.pm * tstep : cA; const char* nB = has_next ? (const char*)g.Bt + (size_t)nxt.pn * tstep : cB;
        for (int t = 0; t < nt; t += 2) {
            const bool last = (t == nt - 2);
            const char* a1 = cA + (size_t)(t + 1) * kstep;
            const char* a2 = last ? nA : cA + (size_t)(t + 2) * kstep; const char* b2 = last ? nB : cB + (size_t)(t + 2) * kstep;
            const char* a3 = a2 + kstep; const char* b3 = b2 + kstep;
            if (last && has_next) S.a_ready(nxt);
            if constexpr (SP2) {
            PG8_LDB(B0, 0, 0); PG8_LDB(B1, 0, 1); PG8_SCHED; PG8_LDA(At, 0, 0); PG8_STAGE(PG8_SA(1, 1), a1 + hstep, voffA);
            PG8_WAIT_V(8); PG8_WAIT_L(0); PG8_BAR; PG8_MMA(0, 0, At, B0); PG8_MMA(0, 1, At, B1); PG8_BAR; PG8_SCHED;
            PG8_LDA(At, 0, 1); PG8_STAGE(PG8_SB(0, 0), b2, voffB); PG8_STAGE(PG8_SB(0, 1), b2 + hstep, voffB); PG8_STAGE(PG8_SA(0, 0), a2, voffA);
            PG8_WAIT_V(8); PG8_WAIT_L(0); PG8_BAR; PG8_MMA(1, 0, At, B0); PG8_MMA(1, 1, At, B1); PG8_BAR; PG8_SCHED;
            PG8_LDB(B0, 1, 0); PG8_LDB(B1, 1, 1); PG8_SCHED; PG8_LDA(At, 1, 0); PG8_STAGE(PG8_SA(0, 1), a2 + hstep, voffA);
            PG8_WAIT_V(8); PG8_WAIT_L(0); PG8_BAR; PG8_MMA(0, 0, At, B0); PG8_MMA(0, 1, At, B1); PG8_BAR; PG8_SCHED;
            PG8_LDA(At, 1, 1); PG8_STAGE(PG8_SB(1, 0), b3, voffB); PG8_STAGE(PG8_SB(1, 1), b3 + hstep, voffB); PG8_STAGE(PG8_SA(1, 0), a3, voffA);
            PG8_WAIT_V(8); PG8_WAIT_L(0); PG8_BAR; PG8_MMA(1, 0, At, B0); PG8_MMA(1, 1, At, B1); PG8_BAR; PG8_SCHED;
            } else {
            PG8_LDB(B0, 0, 0); PG8_SCHED; PG8_LDA(At, 0, 0); PG8_STAGE(PG8_SA(1, 1), a1 + hstep, voffA);
            PG8_WAIT_L(8); PG8_BAR; PG8_WAIT_L(0); PG8_MMA(0, 0, At, B0); PG8_BAR; PG8_SCHED;
            PG8_LDB(B1, 0, 1); PG8_STAGE(PG8_SB(0, 0), b2, voffB);
            PG8_BAR; PG8_WAIT_L(0); PG8_MMA(0, 1, At, B1); PG8_BAR;
            PG8_LDA(At, 0, 1); PG8_STAGE(PG8_SA(0, 0), a2, voffA);
            PG8_BAR; PG8_WAIT_L(0); PG8_MMA(1, 0, At, B0); PG8_BAR; PG8_SCHED;
            PG8_STAGE(PG8_SB(0, 1), b2 + hstep, voffB);
            PG8_WAIT_V(6); PG8_BAR; PG8_MMA(1, 1, At, B1); PG8_BAR;
            PG8_LDB(B0, 1, 0); PG8_SCHED; PG8_LDA(At, 1, 0); PG8_STAGE(PG8_SA(0, 1), a2 + hstep, voffA);
            PG8_WAIT_L(8); PG8_BAR; PG8_WAIT_L(0); PG8_MMA(0, 0, At, B0); PG8_BAR; PG8_SCHED;
            PG8_LDB(B1, 1, 1); PG8_STAGE(PG8_SB(1, 0), b3, voffB);
            PG8_BAR; PG8_WAIT_L(0); PG8_MMA(0, 1, At, B1); PG8_BAR;
            PG8_LDA(At, 1, 1); PG8_STAGE(PG8_SA(1, 0), a3, voffA);
            PG8_BAR; PG8_WAIT_L(0); PG8_MMA(1, 0, At, B0); PG8_BAR; PG8_SCHED;
            PG8_STAGE(PG8_SB(1, 1), b3 + hstep, voffB);
            PG8_WAIT_V(6); PG8_BAR; PG8_MMA(1, 1, At, B1); PG8_BAR;
            }
        }
        if constexpr (ALIGN_EPI) { if (wr == 0) PG8_BAR; }
        if constexpr (!Epi::AFTER_DRAIN) { E(acc, cur, wr, wc, fr, fq); S.done(cur); }
        if (!has_next) break;
#pragma unroll
        for (int a = 0; a < 2; ++a)
#pragma unroll
            for (int b = 0; b < 2; ++b)
#pragma unroll
                for (int m = 0; m < 4; ++m)
#pragma unroll
                    for (int n = 0; n < 2; ++n) acc[a][b][m][n] = (f32x4){0.f, 0.f, 0.f, 0.f};
        cur = nxt; cA = nA; cB = nB; ++ui;
        if constexpr (ALIGN_EPI) { if (wr == 1) PG8_BAR; }
    }
    PG8_WAIT_V(0);
    if constexpr (!ALIGN_EPI) { if (wr == 0) PG8_BAR; }
    PG8_BAR;
    if constexpr (Epi::AFTER_DRAIN) { E.fused(acc, cur, wr, wc, fr, fq, lds, wid, lane); S.done(cur); }
#undef PG8_SA
#undef PG8_SB
#undef PG8_STAGE
#undef PG8_LDA
#undef PG8_LDB
#undef PG8_MMA
#undef PG8_WAIT_V
#undef PG8_WAIT_L
#undef PG8_BAR
#undef PG8_SCHED
}
}
namespace att {
typedef unsigned short bf16_t;
typedef short bf16x8 __attribute__((ext_vector_type(8)));
typedef short s16x4 __attribute__((ext_vector_type(4)));
typedef float f32x16 __attribute__((ext_vector_type(16)));
typedef unsigned u32x4 __attribute__((ext_vector_type(4)));
constexpr int NW = 8, QBLK = 32, KVBLK = 64, QB = NW * QBLK;
constexpr int SHM_V = KVBLK * 128 * 2, SHM_K = KVBLK * 256;
constexpr int LDS_BYTES = 2 * SHM_V + 2 * SHM_K + NW * 64 * 4;
constexpr float SCALE = 0.125f, THR = 8.f;
constexpr int QP = 512, KP = 512, VP = 512, OP = 1024;
#define KSWZ(row, colB) ((row) * 256 + ((colB) ^ (((row) & 7) << 4)))
#define SBAR() __builtin_amdgcn_sched_barrier(0)
__device__ __forceinline__ int v_st(int k, int c) { const int kk = (k & ~0xC) | ((k & 4) << 1) | ((k & 8) >> 1); return ((kk >> 3) * 4 + (c >> 5)) * 512 + ((kk & 7) * 32 + (c & 31)) * 2; }
__device__ __forceinline__ int v_rd_base(int lane) { return ((lane & 3) << 3) | (((lane >> 2) & 3) << 6) | (((lane >> 4) & 1) << 5) | (((lane >> 5) & 1) << 8); }
constexpr int v_rd_off(int d0, int ks, int half) { return d0 * 512 + ks * 4096 + half * 2048; }
__device__ __forceinline__ int crow(int r, int hi) { return (r & 3) + 8 * (r >> 2) + 4 * hi; }
__device__ __forceinline__ unsigned cvtpk(float lo, float hi) { unsigned r; asm volatile("v_cvt_pk_bf16_f32 %0, %1, %2" : "=v"(r) : "v"(lo), "v"(hi)); return r; }
__device__ __forceinline__ bf16x8 load8(const bf16_t* p) { return *reinterpret_cast<const bf16x8*>(p); }
__device__ __forceinline__ void mask_tile(f32x16& p0, f32x16& p1, int dq) {
    const float NEG = -__builtin_inff();
#pragma unroll
    for (int r = 0; r < 16; ++r) {
        const int c = (r & 3) + 8 * (r >> 2);
        if (dq - c < 0) p0[r] = NEG;
        if (dq - c - 32 < 0) p1[r] = NEG;
    }
}
__device__ __forceinline__ void partialSM(f32x16& p0, f32x16& p1, float& m_reg, float& mn, float& alpha) {
    float pmax = p0[0];
#pragma unroll
    for (int r = 1; r < 16; ++r) pmax = fmaxf(pmax, p0[r]);
#pragma unroll
    for (int r = 0; r < 16; ++r) pmax = fmaxf(pmax, p1[r]);
    { auto rr = __builtin_amdgcn_permlane32_swap(__float_as_uint(pmax), __float_as_uint(pmax), false, false);
      pmax = fmaxf(__uint_as_float(rr[0]), __uint_as_float(rr[1])); }
    constexpr float C2 = 1.4426950408889634f * SCALE;
    if (__builtin_expect(__all((pmax - m_reg) * SCALE <= THR), 1)) { mn = m_reg; alpha = 1.f; }
    else { mn = fmaxf(m_reg, pmax); alpha = __builtin_amdgcn_exp2f((m_reg - mn) * C2); m_reg = mn; }
    const float mnL = -mn * C2;
#pragma unroll
    for (int r = 0; r < 16; ++r) p0[r] = fmaf(p0[r], C2, mnL);
#pragma unroll
    for (int r = 0; r < 16; ++r) p1[r] = fmaf(p1[r], C2, mnL);
#pragma unroll
    for (int r = 0; r < 16; ++r) p0[r] = __builtin_amdgcn_exp2f(p0[r]);
}
__device__ __forceinline__ void finishSM(f32x16& p0, f32x16& p1, float alpha, float& l_reg, bf16x8& pa0, bf16x8& pa1, bf16x8& pa2, bf16x8& pa3) {
#pragma unroll
    for (int r = 0; r < 16; ++r) p1[r] = __builtin_amdgcn_exp2f(p1[r]);
    float ps = 0;
#pragma unroll
    for (int r = 0; r < 16; ++r) ps += p0[r];
#pragma unroll
    for (int r = 0; r < 16; ++r) ps += p1[r];
    { auto rr = __builtin_amdgcn_permlane32_swap(__float_as_uint(ps), __float_as_uint(ps), false, false);
      ps = __uint_as_float(rr[0]) + __uint_as_float(rr[1]); }
    l_reg = l_reg * alpha + ps;
#define PK4(P, B_, OUT) do { unsigned a0 = cvtpk(P[B_+0], P[B_+1]), a1 = cvtpk(P[B_+2], P[B_+3]);                          \
        unsigned b0 = cvtpk(P[B_+4], P[B_+5]), b1 = cvtpk(P[B_+6], P[B_+7]);                                             \
        auto r0 = __builtin_amdgcn_permlane32_swap(a0, b0, false, false); auto r1 = __builtin_amdgcn_permlane32_swap(a1, b1, false, false); \
        u32x4 w = {r0[0], r1[0], r0[1], r1[1]}; OUT = *reinterpret_cast<bf16x8*>(&w); } while (0)
    PK4(p0, 0, pa0); PK4(p0, 8, pa1); PK4(p1, 0, pa2); PK4(p1, 8, pa3);
#undef PK4
}
template <int KB>
__device__ __forceinline__ void qkt(f32x16& p0, f32x16& p1, const char* K_lds, int r32, int hi, const bf16x8* qr) {
    p0 = f32x16{}; p1 = f32x16{};
#pragma unroll
    for (int d0 = 0; d0 < 4; ++d0) { const char* a = K_lds + KB * SHM_K + KSWZ(r32, (d0 * 16 + hi * 8) * 2);
        bf16x8 b0 = *reinterpret_cast<const bf16x8*>(a);
        bf16x8 b1 = *reinterpret_cast<const bf16x8*>(a + 32 * 256);
        p0 = __builtin_amdgcn_mfma_f32_32x32x16_bf16(b0, qr[d0], p0, 0, 0, 0);
        p1 = __builtin_amdgcn_mfma_f32_32x32x16_bf16(b1, qr[d0], p1, 0, 0, 0); }
}
template <int VB>
__device__ __forceinline__ void pv_tile(f32x16* o, int vb0, bf16x8 pa0, bf16x8 pa1, bf16x8 pa2, bf16x8 pa3) {
#define TRRD(dst, off) asm volatile("ds_read_b64_tr_b16 %0, %1 offset:%2" : "=&v"(dst) : "v"(vb0), "i"(off) : "memory")
#define PV_D0(d0) do { s16x4 l0, l1, l2, l3, h0, h1, h2, h3; constexpr int b_ = VB * SHM_V + v_rd_off(d0, 0, 0); \
        TRRD(l0, b_); TRRD(h0, b_ + 2048); TRRD(l1, b_ + 4096); TRRD(h1, b_ + 6144); TRRD(l2, b_ + 8192); TRRD(h2, b_ + 10240); TRRD(l3, b_ + 12288); TRRD(h3, b_ + 14336); \
        asm volatile("s_waitcnt lgkmcnt(0)" ::: "memory"); SBAR();   \
        o[d0] = __builtin_amdgcn_mfma_f32_32x32x16_bf16(pa0, (bf16x8){l0[0], l0[1], l0[2], l0[3], h0[0], h0[1], h0[2], h0[3]}, o[d0], 0, 0, 0);   \
        o[d0] = __builtin_amdgcn_mfma_f32_32x32x16_bf16(pa1, (bf16x8){l1[0], l1[1], l1[2], l1[3], h1[0], h1[1], h1[2], h1[3]}, o[d0], 0, 0, 0);   \
        o[d0] = __builtin_amdgcn_mfma_f32_32x32x16_bf16(pa2, (bf16x8){l2[0], l2[1], l2[2], l2[3], h2[0], h2[1], h2[2], h2[3]}, o[d0], 0, 0, 0);   \
        o[d0] = __builtin_amdgcn_mfma_f32_32x32x16_bf16(pa3, (bf16x8){l3[0], l3[1], l3[2], l3[3], h3[0], h3[1], h3[2], h3[3]}, o[d0], 0, 0, 0); } while (0)
    PV_D0(0); PV_D0(1); PV_D0(2); PV_D0(3);
#undef PV_D0
#undef TRRD
}
struct BlockRef { const bf16_t* Q; const bf16_t* K; const bf16_t* V; bf16_t* O; int P0; };
struct Seam { bf16x8 qr[4]; bf16x8 st_v0, st_v1, st_k0; };
#define VMW() asm volatile("s_waitcnt vmcnt(0)" ::: "memory")
#define VMWN(n) asm volatile("s_waitcnt vmcnt(%0)" :: "i"(n) : "memory")
#define SLOAD_H(Kp, Vp, k0) do { S.st_v0 = load8((Vp) + (size_t)((k0) + sr) * VP + sc); S.st_v1 = load8((Vp) + (size_t)((k0) + 32 + sr) * VP + sc);  \
                                 S.st_k0 = load8((Kp) + (size_t)((k0) + kr) * KP + kc); } while (0)
#define SWRITE_HK(bf) do { *(bf16x8*)(K_lds + (bf) * SHM_K + kws) = S.st_k0; } while (0)
#define SWRITE_HV(bf) do { *(bf16x8*)(V_lds + (bf) * SHM_V + vst0) = S.st_v0; *(bf16x8*)(V_lds + (bf) * SHM_V + vst1) = S.st_v1; } while (0)
#define SWRITE_H(bf) do { SWRITE_HV(bf); SWRITE_HK(bf); } while (0)
__device__ __forceinline__ void attn_prime(const BlockRef& cur, char* lds, Seam& S) {
    int tid_l = threadIdx.x; asm volatile("" : "+v"(tid_l));
    const int tid = tid_l, wid = __builtin_amdgcn_readfirstlane(tid >> 6), lane = tid & 63, r32 = lane & 31, hi = lane >> 5;
    const int sr = tid >> 4, sc = (tid & 15) * 8, kr = tid >> 3, kc = (tid & 7) * 8, kws = KSWZ(kr, kc * 2); char* K_lds = lds + 2 * SHM_V;
#pragma unroll
    for (int d0 = 0; d0 < 4; ++d0) S.qr[d0] = load8(cur.Q + (size_t)(wid * QBLK + r32) * QP + d0 * 16 + hi * 8);
    SLOAD_H(cur.K, cur.V, 0); VMW(); SWRITE_HK(0);
    __syncthreads();
}
__device__ __forceinline__ void attn_block(const BlockRef& cur, const BlockRef& nxt, char* lds, Seam& S) {
    int tid_l = threadIdx.x; asm volatile("" : "+v"(tid_l));
    const int tid = tid_l, wid = __builtin_amdgcn_readfirstlane(tid >> 6), lane = tid & 63, r32 = lane & 31, hi = lane >> 5;
    const int NT = (cur.P0 + QB) / KVBLK;
    const int qlo = cur.P0 + wid * QBLK, qm = qlo + r32 - 4 * hi;
    char* V_lds = lds; char* K_lds = lds + 2 * SHM_V;
    float* ws = (float*)(lds + 2 * SHM_V + 2 * SHM_K) + wid * 64; float* li_l = ws, * al_l = ws + 32;
    float m_reg = -1e30f, l_reg = 0; f32x16 o[4] = {};
    const int sr = tid >> 4, sc = (tid & 15) * 8, vst0 = v_st(sr, sc), vst1 = v_st(32 + sr, sc);
    const int kr = tid >> 3, kc = (tid & 7) * 8, kws = KSWZ(kr, kc * 2);
    const int vb0 = (int)(uintptr_t)V_lds + v_rd_base(lane);
    const bf16_t* Kh = cur.K; const bf16_t* Vh = cur.V;
#define RESC(a) do { if (__any((a) < 1.f)) { if (hi == 0) al_l[r32] = (a); asm volatile("s_waitcnt lgkmcnt(0)" ::: "memory");              \
                     _Pragma("unroll") for (int d_ = 0; d_ < 4; ++d_) _Pragma("unroll") for (int r = 0; r < 16; ++r) o[d_][r] *= al_l[crow(r, hi)]; } } while (0)
#define KBASE(t) ((t) * KVBLK)
#define MASKT(P0_, P1_, t) do { const int kb_ = KBASE(t); if (kb_ + KVBLK - 1 > qlo) mask_tile(P0_, P1_, qm - kb_); } while (0)
    constexpr int NQL = 4;
#define SEAM_K0() do { VMWN(NQL); SWRITE_HK(0); SBAR(); } while (0)
    f32x16 pA0, pA1, pB0, pB1; float mnA, mnB, alA, alB; bf16x8 pa0, pa1, pa2, pa3;
    SWRITE_HV(0); SBAR();
    if (NT > 1) { SLOAD_H(Kh, Vh, KBASE(1)); }
    SBAR(); qkt<0>(pA0, pA1, K_lds, r32, hi, S.qr);
    MASKT(pA0, pA1, 0); partialSM(pA0, pA1, m_reg, mnA, alA);
    if (NT > 1) { VMW(); SWRITE_H(1); }
    __syncthreads();
#define HALF_STEP(PX0, PX1, mnX, alX, PY0, PY1, alY, t, KB, VB, SB) do {                                                      \
        SBAR(); qkt<KB>(PX0, PX1, K_lds, r32, hi, S.qr);                                                                      \
        finishSM(PY0, PY1, alY, l_reg, pa0, pa1, pa2, pa3); SBAR();                                                           \
        if ((t) + 1 < NT) { SLOAD_H(Kh, Vh, KBASE((t) + 1)); SBAR(); }                                                       \
        pv_tile<VB>(o, vb0, pa0, pa1, pa2, pa3); MASKT(PX0, PX1, (t)); partialSM(PX0, PX1, m_reg, mnX, alX);                  \
        __syncthreads();                                                                                                      \
        if ((t) + 1 < NT) { VMW(); SWRITE_H(SB); }                                                                            \
        RESC(alX); __syncthreads(); } while (0)
    for (int t = 1; t + 1 < NT; t += 2) {
        HALF_STEP(pB0, pB1, mnB, alB, pA0, pA1, alA, t, 1, 0, 0);
        HALF_STEP(pA0, pA1, mnA, alA, pB0, pB1, alB, t + 1, 0, 1, 1);
    }
    const bool even = (NT & 1) == 0;
    if (even) { SBAR(); qkt<1>(pB0, pB1, K_lds, r32, hi, S.qr); SBAR(); }
    SLOAD_H(nxt.K, nxt.V, 0); SBAR();
#pragma unroll
    for (int d0 = 0; d0 < 4; ++d0) S.qr[d0] = load8(nxt.Q + (size_t)(wid * QBLK + r32) * QP + d0 * 16 + hi * 8);
    SBAR();
    finishSM(pA0, pA1, alA, l_reg, pa0, pa1, pa2, pa3); SBAR();
    pv_tile<0>(o, vb0, pa0, pa1, pa2, pa3);
    if (even) { MASKT(pB0, pB1, NT - 1); partialSM(pB0, pB1, m_reg, mnB, alB); __syncthreads(); RESC(alB);
        finishSM(pB0, pB1, alB, l_reg, pa0, pa1, pa2, pa3); SBAR(); pv_tile<1>(o, vb0, pa0, pa1, pa2, pa3); }
    SBAR(); SEAM_K0();
    if (hi == 0) li_l[r32] = l_reg; asm volatile("s_waitcnt lgkmcnt(0)" ::: "memory");
    float rli[16];
#pragma unroll
    for (int r = 0; r < 16; ++r) rli[r] = __builtin_amdgcn_rcpf(li_l[crow(r, hi)]);
    bf16_t* Ow = cur.O + (size_t)(wid * QBLK) * OP;
#pragma unroll
    for (int r = 0; r < 16; ++r) { const int orow = crow(r, hi);
#pragma unroll
        for (int d0 = 0; d0 < 4; ++d0) { const float v = o[d0][r] * rli[r];
            const float vn = __shfl_xor(v, 1);
            if ((r32 & 1) == 0) *(unsigned*)(Ow + (size_t)orow * OP + d0 * 32 + r32) = cvtpk(v, vn); } }
    __syncthreads();
#undef RESC
#undef KBASE
#undef MASKT
#undef SEAM_K0
#undef HALF_STEP
}
#undef VMW
#undef VMWN
#undef SLOAD_H
#undef SWRITE_HK
#undef SWRITE_HV
#undef SWRITE_H
#undef KSWZ
#undef SBAR
}
#define GAS __attribute__((address_space(1)))
#define LAS __attribute__((address_space(3)))
typedef unsigned short bf16;
typedef unsigned v4u __attribute__((ext_vector_type(4)));
typedef float f32x4 __attribute__((ext_vector_type(4)));
typedef short bf16x8 __attribute__((ext_vector_type(8)));
typedef GAS unsigned gu32;
typedef GAS unsigned long long gu64;
#define RLX_AGENT __ATOMIC_RELAXED, __HIP_MEMORY_SCOPE_AGENT
#define LDS_WAIT() asm volatile("s_waitcnt lgkmcnt(0)" ::: "memory")
#define VM_WAIT() asm volatile("s_waitcnt vmcnt(0)" ::: "memory")
__device__ __forceinline__ unsigned long long rt() { return __builtin_amdgcn_s_memrealtime(); }
__device__ __forceinline__ unsigned f2bf(float f) { unsigned u = __builtin_bit_cast(unsigned, f); return (u + 0x7fffu + ((u >> 16) & 1u)) >> 16; }
__device__ __forceinline__ unsigned pk2(float lo, float hi) { return f2bf(lo) | (f2bf(hi) << 16); }

#define XB_TMO      128
#define XB_XCNT(j)  (256  + 64 * (j))
#define XB_XSUB(j)  (1280 + 64 * (j))
#define XB_XGEN(j)  (2304 + 64 * (j))
#define XB_TOP      3328
#define XB_TOPGEN   3392
#define XCD_BAR_WORDS 3456
#define XB_SPIN_CAP (1u << 18)

__device__ __forceinline__ unsigned xb_ld(unsigned* p)              { return __hip_atomic_load(p, __ATOMIC_RELAXED, __HIP_MEMORY_SCOPE_AGENT); }
__device__ __forceinline__ unsigned xb_add(unsigned* p, unsigned v) { return __hip_atomic_fetch_add(p, v, __ATOMIC_RELAXED, __HIP_MEMORY_SCOPE_AGENT); }
__device__ __forceinline__ unsigned xb_xcc_id() { return (unsigned)__builtin_amdgcn_s_getreg((3 << 11) | 20) & 0xFu; }
#define XB_SPIN(cond, bar) do { unsigned _sp = 0; while (cond) { __builtin_amdgcn_s_sleep(1); \
    if ((++_sp & 255u) == 0u) { if (xb_ld(&(bar)[XB_TMO])) break; if (_sp > XB_SPIN_CAP) { atomicAdd(&(bar)[XB_TMO], 1u); break; } } } } while (0)

struct XcdBarrier {
    unsigned* bar; unsigned x;
    volatile LAS unsigned* st;
};

__device__ __forceinline__ XcdBarrier xcd_barrier_post(unsigned* bar, volatile LAS unsigned* st) {
    XcdBarrier b; b.bar = bar; b.x = xb_xcc_id(); b.st = st;
    if (threadIdx.x == 0) (void)xb_add(&bar[XB_XCNT(b.x)], 1u);
    return b;
}
__device__ __forceinline__ void xcd_barrier_complete(unsigned* bar, unsigned x, unsigned& nloc, unsigned& nx) {
    const unsigned G = gridDim.x * gridDim.y * gridDim.z;
    unsigned sum, cnt, mine, sp = 0u;
    for (;;) {
        sum = 0u; cnt = 0u; mine = 0u;
#pragma unroll
        for (unsigned j = 0; j < 16; ++j) { const unsigned c = xb_ld(&bar[XB_XCNT(j)]); sum += c; cnt += (c > 0u) ? 1u : 0u; mine = (j == x) ? c : mine; }
        if (sum == G) break;
        __builtin_amdgcn_s_sleep(1);
        if ((++sp & 255u) == 0u) { if (xb_ld(&bar[XB_TMO])) break; if (sp > XB_SPIN_CAP) { atomicAdd(&bar[XB_TMO], 1u); break; } }
    }
    nloc = mine > 0u ? mine : 1u; nx = cnt > 0u ? cnt : 1u;
}

__device__ __forceinline__ void xcd_barrier(const XcdBarrier& b) {
    asm volatile("s_waitcnt vmcnt(0)" ::: "memory");
    __syncthreads();
    if (threadIdx.x == 0) {
        unsigned* bar = b.bar;
        __builtin_amdgcn_s_waitcnt(0);
        unsigned nloc = b.st[0], nx = b.st[1];
        if (nloc == 0u) { xcd_barrier_complete(bar, b.x, nloc, nx); b.st[0] = nloc; b.st[1] = nx; }
        const unsigned old = xb_add(&bar[XB_XSUB(b.x)], 1u);
        const unsigned gen = old / nloc;
        if (old + 1u == (gen + 1u) * nloc) {
            __builtin_amdgcn_fence(__ATOMIC_RELEASE, "agent");
            asm volatile("s_waitcnt vmcnt(0)" ::: "memory");
            const unsigned og = xb_add(&bar[XB_TOP], 1u);
            const unsigned tg = og / nx;
            if (og + 1u == (tg + 1u) * nx) xb_add(&bar[XB_TOPGEN], 1u);
            else XB_SPIN(xb_ld(&bar[XB_TOPGEN]) == tg, bar);
            __builtin_amdgcn_fence(__ATOMIC_ACQUIRE, "agent");
            xb_add(&bar[XB_XGEN(b.x)], 1u);
            asm volatile("s_waitcnt vmcnt(0)" ::: "memory");
        } else {
            XB_SPIN(xb_ld(&bar[XB_XGEN(b.x)]) == gen, bar);
            __builtin_amdgcn_fence(__ATOMIC_ACQUIRE, "agent");
            asm volatile("s_waitcnt vmcnt(0)" ::: "memory");
        }
    }
    __syncthreads();
}
constexpr int NWAVES = 8;
constexpr int DM = 1024, MP = pg8::MP, MS = pg8::MS, MT = pg8::MT, SEQ = 8192, NIN = 3072, DFF = 2816, NUP = 2 * DFF;
constexpr int DEC_B = 128, DEC_T = 4, N_PAGES = 16, PAGE = 128, N_ITEMS = 17;
constexpr size_t MiB = 1u << 20;
constexpr size_t WS_CTL = 0, CTL_ZERO_BYTES = 1 * MiB;
constexpr size_t WS_TAB = 1 * MiB;
constexpr size_t TAB_COSD = WS_TAB, TAB_SIND = TAB_COSD + 262144, TAB_COSR = TAB_SIND + 262144, TAB_SINR = TAB_COSR + 1048576;
constexpr size_t WS_WIN = 4 * MiB, WS_WOUT = 10 * MiB, WS_WUP = 12 * MiB, WS_WDN = 23 * MiB;
constexpr size_t WS_XN = 32 * MiB;
constexpr size_t WS_DQ = 66 * MiB, WS_DK = 83 * MiB, WS_DV = 100 * MiB, WS_RV = 117 * MiB, WS_RG = 134 * MiB;
constexpr size_t WS_RQ = 151 * MiB, WS_RK = 160 * MiB;
constexpr size_t WS_OA = 169 * MiB;
constexpr size_t WS_CAT = 202 * MiB;
constexpr size_t WS_DECO = 236 * MiB;
constexpr size_t WS_DECML = 271 * MiB;
constexpr size_t WS_KV = 272 * MiB;
constexpr size_t WS_ST = 288 * MiB;
constexpr size_t WS_X1 = 296 * MiB;
constexpr size_t WS_X1B = 362 * MiB;
constexpr size_t WS_SSQ = 395 * MiB;
constexpr size_t WS_H = 397 * MiB;
constexpr size_t WS_END = 488 * MiB;
constexpr int CW_TMO = 0, CW_CODE = 1, CW_BAR = 4096;
constexpr int RING_OFF = 0, RING_BYTES = 131072;
constexpr int LDSCTL_OFF = RING_BYTES, MISC_OFF = LDSCTL_OFF + 320;
constexpr int LDS_BYTES = 147456;
static_assert(att::LDS_BYTES <= RING_BYTES && pg8::STAGE_BYTES <= RING_BYTES, "LDS map");

__constant__ double INV_D[8] = {1, 0.19392274474868576, 0.037606030930863933, 0.0072926647372171093, 0.001414213562373095, 0.0002742481756762073, 5.3182958969449883e-05, 1.031338537721246e-05};
__constant__ double INV_R[32] = {1, 0.74989420933245587, 0.56234132519034907, 0.42169650342858223, 0.31622776601683794, 0.23713737056616552, 0.17782794100389229, 0.1333521432163324, 0.10000000000000001, 0.074989420933245579, 0.056234132519034911, 0.042169650342858224, 0.031622776601683791, 0.023713737056616554, 0.017782794100389229, 0.013335214321633241, 0.01, 0.0074989420933245579, 0.005623413251903491, 0.0042169650342858229, 0.0031622776601683794, 0.0023713737056616554, 0.0017782794100389228, 0.0013335214321633241, 0.001, 0.00074989420933245586, 0.0005623413251903491, 0.00042169650342858224, 0.00031622776601683794, 0.00023713737056616554, 0.00017782794100389227, 0.0001333521432163324};
__device__ __forceinline__ float log2_gamma(int h) { return h == 0 ? -0.045803689613124789f : h == 1 ? -0.022720076500083529f : h == 2 ? -0.011315313227834146f : -0.0056465631411420627f; }

struct Frame {
    LAS unsigned char* lds;
    volatile LAS unsigned* MISC;
    gu32* ctl;
    int tid, lane, wave, vcu, G;
};
__device__ __forceinline__ float wave_sum(float v) {
#pragma unroll
    for (int o = 1; o < 64; o <<= 1) v += __shfl_xor(v, o);
    return v;
}
__device__ __forceinline__ float bf2f(bf16 b) { return __uint_as_float((unsigned)b << 16); }
__device__ __forceinline__ float bflo(unsigned w) { return __uint_as_float(w << 16); }
__device__ __forceinline__ float bfhi(unsigned w) { return __uint_as_float(w & 0xffff0000u); }

__device__ __forceinline__ int perm_in(int n) {
    if (n < 1024) { const int d = n & 63; if (d < 16) { const int i = d & 7, half = d >> 3; return (n & ~63) + ((i >> 2) << 3) + (half << 2) + (i & 3); } return n; }
    if (n >= 1536 && n < 2048) { const int d = n & 63, i = d & 31, half = d >> 5; return (n & ~63) + ((i >> 2) << 3) + (half << 2) + (i & 3); }
    return n;
}
__device__ __forceinline__ int perm_up(int n) { const int part = n >= DFF ? 1 : 0, f = part ? n - DFF : n; return ((f >> 2) << 3) + (part << 2) + (f & 3); }
template <int PERM>
__device__ __forceinline__ void p0_transpose_item(const float* W, int K, int N, bf16* WT, const float* gain, LAS float* scr, int item, int lane) {
    const int nblk = N / 32, kb = item / nblk, nb = item % nblk, k0 = 64 * kb, n0 = 32 * nb;
#pragma unroll 8
    for (int i = 0; i < 32; ++i) { const int kk = 2 * i + (lane >> 5); float w = W[(size_t)(k0 + kk) * N + n0 + (lane & 31)]; if (gain) w *= gain[k0 + kk]; scr[kk * 33 + (lane & 31)] = w; }
    LDS_WAIT(); asm volatile("" ::: "memory");
    const int c = lane & 7;
#pragma unroll
    for (int j = 0; j < 4; ++j) { const int n = (lane >> 3) + 8 * j; const LAS float* s = scr + (8 * c) * 33 + n;
        v4u o; o.x = pk2(s[0 * 33], s[1 * 33]); o.y = pk2(s[2 * 33], s[3 * 33]); o.z = pk2(s[4 * 33], s[5 * 33]); o.w = pk2(s[6 * 33], s[7 * 33]);
        const int nl = n0 + n, np = PERM == 1 ? perm_in(nl) : PERM == 2 ? perm_up(nl) : nl;
        *(GAS v4u*)(WT + (size_t)np * K + k0 + 8 * c) = o; }
    LDS_WAIT(); asm volatile("" ::: "memory");
}
__device__ __forceinline__ void rms_row_to_bf16(int lane, const float* xrow, const float* g, bf16* orow) {
    const GAS f32x4* xr = (const GAS f32x4*)xrow + lane; const GAS f32x4* gr = (const GAS f32x4*)g + lane;
    f32x4 v[4]; float s = 0.f;
#pragma unroll
    for (int j = 0; j < 4; ++j) { v[j] = xr[64 * j]; s += (v[j].x * v[j].x + v[j].y * v[j].y) + (v[j].z * v[j].z + v[j].w * v[j].w); }
    const float r = 1.f / sqrtf(wave_sum(s) * (1.f / DM) + 1e-6f);
    GAS unsigned long long* o8 = (GAS unsigned long long*)orow + lane;
#pragma unroll
    for (int j = 0; j < 4; ++j) { const f32x4 gg = gr[64 * j]; o8[64 * j] = (unsigned long long)pk2(v[j].x * r * gg.x, v[j].y * r * gg.y) | ((unsigned long long)pk2(v[j].z * r * gg.z, v[j].w * r * gg.w) << 32); }
}
__device__ __forceinline__ void sincos_d(double x, float& s, float& c) {
    const double k = __builtin_rint(x * 0.63661977236758134308);
    double r = __builtin_fma(-k, 1.57079632679489655800e+00, x); r = __builtin_fma(-k, 6.12323399573676603587e-17, r);
    const double r2 = r * r;
    const double sp = r * (1.0 + r2 * (-1.0 / 6 + r2 * (1.0 / 120 + r2 * (-1.0 / 5040 + r2 * (1.0 / 362880 + r2 * (-1.0 / 39916800 + r2 * (1.0 / 6227020800.0)))))));
    const double cp = 1.0 + r2 * (-0.5 + r2 * (1.0 / 24 + r2 * (-1.0 / 720 + r2 * (1.0 / 40320 + r2 * (-1.0 / 3628800 + r2 * (1.0 / 479001600.0 + r2 * (-1.0 / 87178291200.0)))))));
    const int q = ((int)k) & 3;
    const double ss = (q == 0) ? sp : (q == 1) ? cp : (q == 2) ? -sp : -cp;
    const double cc = (q == 0) ? cp : (q == 1) ? -sp : (q == 2) ? -cp : sp;
    s = (float)ss; c = (float)cc;
}

typedef float f32x4m __attribute__((ext_vector_type(4)));
__device__ __forceinline__ bf16x8 lfrag(const LAS unsigned char* base, int row, int ldb, int kbyte) { return *(const LAS bf16x8*)(base + row * ldb + kbyte); }
#define MFMA16(a, b, c) __builtin_amdgcn_mfma_f32_16x16x32_bf16((a), (b), (c), 0, 0, 0)

constexpr int LDT = 136 * 2;
constexpr int LDH = 72 * 2;
__device__ __forceinline__ void ret_kv_unit(Frame& F, int bh, int c, const bf16* RK, const bf16* RV, float* KV) {
    LAS unsigned char* VT = F.lds;
    LAS unsigned char* KT = F.lds + 128 * LDT;
    const int b = bh >> 2, h = bh & 3; const size_t R0 = (size_t)b * SEQ + (size_t)c * 128;
    const float lg = log2_gamma(h);
    for (int idx = F.tid; idx < 2048; idx += 512) { const int j = idx & 127, ec = idx >> 7;
        const v4u w = *(const GAS v4u*)(RV + (R0 + j) * 512 + h * 128 + ec * 8);
        const unsigned ww[4] = {w.x, w.y, w.z, w.w};
#pragma unroll
        for (int q = 0; q < 4; ++q) { *(LAS bf16*)(VT + (ec * 8 + 2 * q) * LDT + j * 2) = (bf16)(ww[q] & 0xffffu); *(LAS bf16*)(VT + (ec * 8 + 2 * q + 1) * LDT + j * 2) = (bf16)(ww[q] >> 16); } }
    for (int idx = F.tid; idx < 1024; idx += 512) { const int j = idx & 127, dc = idx >> 7;
        const v4u w = *(const GAS v4u*)(RK + (R0 + j) * 256 + h * 64 + dc * 8);
        const float dec = __builtin_amdgcn_exp2f(lg * (float)(127 - j));
        const unsigned ww[4] = {w.x, w.y, w.z, w.w};
#pragma unroll
        for (int q = 0; q < 4; ++q) { *(LAS bf16*)(KT + (dc * 8 + 2 * q) * LDT + j * 2) = (bf16)f2bf(bflo(ww[q]) * dec); *(LAS bf16*)(KT + (dc * 8 + 2 * q + 1) * LDT + j * 2) = (bf16)f2bf(bfhi(ww[q]) * dec); } }
    LDS_WAIT(); __syncthreads();
    const int fr = F.lane & 15, fq = F.lane >> 4, w = F.wave;
    f32x4m acc[4];
#pragma unroll
    for (int nj = 0; nj < 4; ++nj) acc[nj] = (f32x4m){0.f, 0.f, 0.f, 0.f};
#pragma unroll
    for (int ks = 0; ks < 4; ++ks) { const bf16x8 a = lfrag(VT, 16 * w + fr, LDT, (32 * ks + 8 * fq) * 2);
#pragma unroll
        for (int nj = 0; nj < 4; ++nj) acc[nj] = MFMA16(a, lfrag(KT, 16 * nj + fr, LDT, (32 * ks + 8 * fq) * 2), acc[nj]); }
    float* dst = KV + ((size_t)bh * 64 + c) * 8192;
#pragma unroll
    for (int nj = 0; nj < 4; ++nj)
#pragma unroll
        for (int r = 0; r < 4; ++r) dst[(16 * w + 4 * fq + r) * 64 + 16 * nj + fr] = acc[nj][r];
    __syncthreads();
}
__device__ __forceinline__ void ret_out_unit(Frame& F, int bh, int c, const bf16* RQ, const bf16* RK, const bf16* RV, const bf16* RGs, const bf16* ST, bf16* CAT) {
    LAS unsigned char* Qs = F.lds;
    LAS unsigned char* Ks = Qs + 128 * LDH;
    LAS unsigned char* VT = Ks + 128 * LDH;
    LAS unsigned char* STs = VT + 128 * LDT;
    LAS unsigned char* Ps = STs + 128 * LDH;
    LAS float* OS = (LAS float*)F.lds;
    static_assert(128 * LDH * 3 + 128 * LDT * 2 <= RING_BYTES && 128 * 132 * 4 <= 128 * LDH * 2 + 128 * LDT, "retention LDS map");
    const int b = bh >> 2, h = bh & 3; const size_t R0 = (size_t)b * SEQ + (size_t)c * 128;
    const float lg = log2_gamma(h);
    for (int idx = F.tid; idx < 1024; idx += 512) { const int i = idx >> 3, ch = idx & 7;
        const v4u q = *(const GAS v4u*)(RQ + (R0 + i) * 256 + h * 64 + ch * 8);
        *(LAS v4u*)(Qs + i * LDH + ch * 16) = q;
        *(LAS v4u*)(Ks + i * LDH + ch * 16) = *(const GAS v4u*)(RK + (R0 + i) * 256 + h * 64 + ch * 8);
        *(LAS v4u*)(STs + i * LDH + ch * 16) = *(const GAS v4u*)(ST + ((size_t)bh * 64 + c) * 8192 + i * 64 + ch * 8); }
    for (int idx = F.tid; idx < 2048; idx += 512) { const int j = idx & 127, ec = idx >> 7;
        const v4u w = *(const GAS v4u*)(RV + (R0 + j) * 512 + h * 128 + ec * 8);
        const unsigned ww[4] = {w.x, w.y, w.z, w.w};
#pragma unroll
        for (int q = 0; q < 4; ++q) { *(LAS bf16*)(VT + (ec * 8 + 2 * q) * LDT + j * 2) = (bf16)(ww[q] & 0xffffu); *(LAS bf16*)(VT + (ec * 8 + 2 * q + 1) * LDT + j * 2) = (bf16)(ww[q] >> 16); } }
    LDS_WAIT(); __syncthreads();
    const int fr = F.lane & 15, fq = F.lane >> 4, w = F.wave;
    const int njmax = w | 1;
#pragma unroll
    for (int nj = 0; nj < 8; ++nj) if (nj <= njmax) {
        f32x4m s = (f32x4m){0.f, 0.f, 0.f, 0.f};
#pragma unroll
        for (int ks = 0; ks < 2; ++ks) s = MFMA16(lfrag(Qs, 16 * w + fr, LDH, (32 * ks + 8 * fq) * 2), lfrag(Ks, 16 * nj + fr, LDH, (32 * ks + 8 * fq) * 2), s);
#pragma unroll
        for (int r = 0; r < 4; ++r) { const int i = 16 * w + 4 * fq + r, j = 16 * nj + fr;
            const float p = (j <= i) ? s[r] * __builtin_amdgcn_exp2f(lg * (float)(i - j)) : 0.f;
            *(LAS bf16*)(Ps + i * LDT + j * 2) = (bf16)f2bf(p); }
    }
    LDS_WAIT(); asm volatile("" ::: "memory");
    f32x4m acc[8];
#pragma unroll
    for (int nj = 0; nj < 8; ++nj) acc[nj] = (f32x4m){0.f, 0.f, 0.f, 0.f};
    const int ksmax = w >> 1;
#pragma unroll
    for (int ks = 0; ks < 4; ++ks) if (ks <= ksmax) { const bf16x8 a = lfrag(Ps, 16 * w + fr, LDT, (32 * ks + 8 * fq) * 2);
#pragma unroll
        for (int nj = 0; nj < 8; ++nj) acc[nj] = MFMA16(a, lfrag(VT, 16 * nj + fr, LDT, (32 * ks + 8 * fq) * 2), acc[nj]); }
    const float qdec = __builtin_amdgcn_exp2f(lg * (float)(16 * w + fr + 1));
#pragma unroll
    for (int ks = 0; ks < 2; ++ks) { const v4u qq = *(const LAS v4u*)(Qs + (16 * w + fr) * LDH + (32 * ks + 8 * fq) * 2);
        v4u q2; q2.x = pk2(bflo(qq.x) * qdec, bfhi(qq.x) * qdec); q2.y = pk2(bflo(qq.y) * qdec, bfhi(qq.y) * qdec); q2.z = pk2(bflo(qq.z) * qdec, bfhi(qq.z) * qdec); q2.w = pk2(bflo(qq.w) * qdec, bfhi(qq.w) * qdec);
        const bf16x8 a = __builtin_bit_cast(bf16x8, q2);
#pragma unroll
        for (int nj = 0; nj < 8; ++nj) acc[nj] = MFMA16(a, lfrag(STs, 16 * nj + fr, LDH, (32 * ks + 8 * fq) * 2), acc[nj]); }
    float rinv[4];
#pragma unroll
    for (int r = 0; r < 4; ++r) { float ss = 0.f;
#pragma unroll
        for (int nj = 0; nj < 8; ++nj) ss += acc[nj][r] * acc[nj][r];
        ss += __shfl_xor(ss, 1); ss += __shfl_xor(ss, 2); ss += __shfl_xor(ss, 4); ss += __shfl_xor(ss, 8);
        rinv[r] = 1.f / sqrtf(ss * (1.f / 128.f) + 1e-6f); }
    __syncthreads();
#pragma unroll
    for (int nj = 0; nj < 8; ++nj)
#pragma unroll
        for (int r = 0; r < 4; ++r) OS[(16 * w + 4 * fq + r) * 132 + 16 * nj + fr] = acc[nj][r] * rinv[r];
    LDS_WAIT(); __syncthreads();
    for (int idx = F.tid; idx < 2048; idx += 512) { const int i = idx >> 4, ec = idx & 15;
        const v4u g = *(const GAS v4u*)(RGs + (R0 + i) * 512 + h * 128 + ec * 8);
        const LAS float* os = OS + i * 132 + ec * 8;
        v4u o; o.x = pk2(os[0] * bflo(g.x), os[1] * bfhi(g.x)); o.y = pk2(os[2] * bflo(g.y), os[3] * bfhi(g.y)); o.z = pk2(os[4] * bflo(g.z), os[5] * bfhi(g.z)); o.w = pk2(os[6] * bflo(g.w), os[7] * bfhi(g.w));
        *(GAS v4u*)(CAT + (R0 + i) * 1024 + 512 + h * 128 + ec * 8) = o; }
    LDS_WAIT(); __syncthreads();
}

__device__ __forceinline__ float row16_sum(float v) {
    v += __int_as_float(__builtin_amdgcn_update_dpp(0, __float_as_int(v), 0x128, 0xf, 0xf, false));
    v += __int_as_float(__builtin_amdgcn_update_dpp(0, __float_as_int(v), 0x124, 0xf, 0xf, false));
    v += __int_as_float(__builtin_amdgcn_update_dpp(0, __float_as_int(v), 0x122, 0xf, 0xf, false));
    v += __int_as_float(__builtin_amdgcn_update_dpp(0, __float_as_int(v), 0x121, 0xf, 0xf, false));
    return v;
}
__device__ __forceinline__ f32x4 ntld4(const float* p) { return __builtin_nontemporal_load((const f32x4*)p); }
__device__ __forceinline__ void decode_item(const float* __restrict__ Kb, const float* __restrict__ Vb, int ntok, bool newtok, const bf16* qrows, LAS float* scr, float* po, float* pml, int lane) {
    const int hml = lane >> 4, c = lane & 15, row = lane >> 1, half = lane & 1, hl = lane >> 5;
    constexpr float QS = 0.125f * 1.4426950408889634f;
    f32x4 qv[2][4];
#pragma unroll
    for (int v = 0; v < 2; ++v)
#pragma unroll
        for (int tq = 0; tq < 4; ++tq) { const unsigned long long w = *(const GAS unsigned long long*)(qrows + tq * 512 + (4 * v + hml) * 64 + 4 * c);
            qv[v][tq] = (f32x4){bflo((unsigned)w) * QS, bfhi((unsigned)w) * QS, bflo((unsigned)(w >> 32)) * QS, bfhi((unsigned)(w >> 32)) * QS}; }
    f32x4 o[2][4][2];
#pragma unroll
    for (int v = 0; v < 2; ++v)
#pragma unroll
        for (int tq = 0; tq < 4; ++tq) { o[v][tq][0] = (f32x4){0.f, 0.f, 0.f, 0.f}; o[v][tq][1] = (f32x4){0.f, 0.f, 0.f, 0.f}; }
    float m_run = -1e30f, l_run = 0.f;
    const float NEG = -__builtin_inff();
    for (int t0 = 0; t0 < ntok; t0 += 16) {
#pragma unroll 1
        for (int tt = 0; tt < 16; tt += 4) {
            f32x4 kk[4][2];
#pragma unroll
            for (int i = 0; i < 4; ++i)
#pragma unroll
                for (int v = 0; v < 2; ++v) { const int t = t0 + tt + i; kk[i][v] = (t < ntok) ? ntld4(Kb + (size_t)t * 512 + v * 256 + lane * 4) : (f32x4){0.f, 0.f, 0.f, 0.f}; }
#pragma unroll
            for (int i = 0; i < 4; ++i)
#pragma unroll
                for (int v = 0; v < 2; ++v) { const int t = t0 + tt + i; float s[4];
#pragma unroll
                    for (int tq = 0; tq < 4; ++tq) { const f32x4 p = qv[v][tq] * kk[i][v]; s[tq] = row16_sum((p[0] + p[1]) + (p[2] + p[3])); }
                    float sv = (c == 0) ? s[0] : (c == 1) ? s[1] : (c == 2) ? s[2] : s[3];
                    if (t >= ntok || (newtok && t > c)) sv = NEG;
                    if (c < 4) scr[(tt + i) * 32 + (4 * v + hml) * 4 + c] = sv; }
        }
        asm volatile("s_waitcnt lgkmcnt(0)" ::: "memory");
        { float sv[8]; float bm = NEG;
#pragma unroll
            for (int i = 0; i < 8; ++i) { sv[i] = scr[(half * 8 + i) * 32 + row]; bm = fmaxf(bm, sv[i]); }
            bm = fmaxf(bm, __shfl_xor(bm, 1));
            const float mn = fmaxf(m_run, bm), alpha = __builtin_amdgcn_exp2f(m_run - mn); float ps = 0.f;
#pragma unroll
            for (int i = 0; i < 8; ++i) { const float p = __builtin_amdgcn_exp2f(sv[i] - mn); ps += p; scr[(half * 8 + i) * 32 + row] = p; }
            ps += __shfl_xor(ps, 1);
            l_run = l_run * alpha + ps; m_run = mn;
            if (half == 0) scr[512 + row] = alpha; }
        asm volatile("s_waitcnt lgkmcnt(0)" ::: "memory");
#pragma unroll
        for (int v = 0; v < 2; ++v) { const int h = 2 * v + hl; const f32x4 a0 = *(const LAS f32x4*)(scr + 512 + (h * 2 + 0) * 4), a1 = *(const LAS f32x4*)(scr + 512 + (h * 2 + 1) * 4);
#pragma unroll
            for (int tq = 0; tq < 4; ++tq) { o[v][tq][0] = o[v][tq][0] * a0[tq]; o[v][tq][1] = o[v][tq][1] * a1[tq]; } }
#pragma unroll 1
        for (int tt = 0; tt < 16; tt += 4) {
            f32x4 vv[4][2];
#pragma unroll
            for (int i = 0; i < 4; ++i)
#pragma unroll
                for (int v = 0; v < 2; ++v) { const int t = t0 + tt + i; vv[i][v] = (t < ntok) ? ntld4(Vb + (size_t)t * 512 + v * 256 + lane * 4) : (f32x4){0.f, 0.f, 0.f, 0.f}; }
#pragma unroll
            for (int i = 0; i < 4; ++i)
#pragma unroll
                for (int v = 0; v < 2; ++v) { const int h = 2 * v + hl;
                    const f32x4 p0 = *(const LAS f32x4*)(scr + (tt + i) * 32 + (h * 2 + 0) * 4), p1 = *(const LAS f32x4*)(scr + (tt + i) * 32 + (h * 2 + 1) * 4);
#pragma unroll
                    for (int tq = 0; tq < 4; ++tq) { o[v][tq][0] += vv[i][v] * p0[tq]; o[v][tq][1] += vv[i][v] * p1[tq]; } }
        }
        asm volatile("s_waitcnt lgkmcnt(0)" ::: "memory");
    }
    if (half == 0) { pml[row * 2] = m_run; pml[row * 2 + 1] = l_run; }
#pragma unroll
    for (int v = 0; v < 2; ++v)
#pragma unroll
        for (int tq = 0; tq < 4; ++tq)
#pragma unroll
            for (int m = 0; m < 2; ++m) *(f32x4*)(po + (((2 * v + hl) * 2 + m) * 4 + tq) * 128 + 4 * (lane & 31)) = o[v][tq][m];
}

__device__ __forceinline__ void sample_ret_item(int db, int h, int lane, const bf16* RQ, const bf16* RK, const bf16* RV, const bf16* RGs, const float* state, float* sout, bf16* CAT) {
    typedef float f32x2 __attribute__((ext_vector_type(2)));
    const int rowb = MP + db * 4; const float lg = log2_gamma(h);
    float qd[4], kd[4]; f32x2 vv[4];
#pragma unroll
    for (int i = 0; i < 4; ++i) { qd[i] = bf2f(RQ[(size_t)(rowb + i) * 256 + h * 64 + lane]); kd[i] = bf2f(RK[(size_t)(rowb + i) * 256 + h * 64 + lane]);
        const unsigned w = *(const GAS unsigned*)(RV + (size_t)(rowb + i) * 512 + h * 128 + 2 * lane); vv[i] = (f32x2){bflo(w), bfhi(w)}; }
    float gp[5];
#pragma unroll
    for (int n = 0; n < 5; ++n) gp[n] = __builtin_amdgcn_exp2f(lg * (float)n);
    f32x2 outv[4];
#pragma unroll
    for (int i = 0; i < 4; ++i) { outv[i] = (f32x2){0.f, 0.f};
#pragma unroll
        for (int j = 0; j <= i; ++j) { const float qk = wave_sum(qd[i] * kd[j]) * gp[i - j]; outv[i] += vv[j] * qk; } }
    const float* S = state + ((size_t)(db * 4 + h) * 64) * 128; float* SO = sout + ((size_t)(db * 4 + h) * 64) * 128;
    f32x2 cr[4] = {(f32x2){0.f, 0.f}, (f32x2){0.f, 0.f}, (f32x2){0.f, 0.f}, (f32x2){0.f, 0.f}};
#pragma unroll 4
    for (int d = 0; d < 64; ++d) {
        const f32x2 s = *(const f32x2*)(S + d * 128 + 2 * lane);
        f32x2 ns = s * gp[4];
#pragma unroll
        for (int i = 0; i < 4; ++i) { const float qs = __int_as_float(__builtin_amdgcn_readlane(__float_as_int(qd[i]), d)); cr[i] += s * qs;
            const float ks = __int_as_float(__builtin_amdgcn_readlane(__float_as_int(kd[i]), d)) * gp[3 - i]; ns += vv[i] * ks; }
        *(f32x2*)(SO + d * 128 + 2 * lane) = ns;
    }
#pragma unroll
    for (int i = 0; i < 4; ++i) { const f32x2 ov = outv[i] + cr[i] * gp[i + 1];
        const float ss = wave_sum(ov.x * ov.x + ov.y * ov.y); const float r = 1.f / sqrtf(ss * (1.f / 128.f) + 1e-6f);
        const unsigned g = *(const GAS unsigned*)(RGs + (size_t)(rowb + i) * 512 + h * 128 + 2 * lane);
        *(GAS unsigned*)(CAT + (size_t)(rowb + i) * 1024 + 512 + h * 128 + 2 * lane) = pk2(ov.x * r * bflo(g), ov.y * r * bfhi(g)); }
}

#define PHASE_BEGIN() unsigned char* wsl = args.ws; { int t_ = threadIdx.x; asm volatile("" : "+v"(t_)); F.tid = t_; F.lane = t_ & 63; F.wave = __builtin_amdgcn_readfirstlane(t_ >> 6); asm volatile("" : "+s"(wsl)); } \
    float* out = args.out; const int gw = F.vcu * NWAVES + F.wave, NGW = F.G * NWAVES, gt = F.vcu * (NWAVES * 64) + F.tid, NGT = F.G * NWAVES * 64; (void)out; (void)gw; (void)NGW; (void)gt; (void)NGT
#define WSP(type, off) ((type*)(wsl + (off)))
struct Args { const float* in[15]; float* out; unsigned char* ws; };
__global__ void __launch_bounds__(NWAVES * 64, 2) hymba_fwd(Args args) {
    extern __shared__ __attribute__((aligned(16))) unsigned char lds[];
    Frame F;
    F.lds = (LAS unsigned char*)lds;
    F.MISC = (volatile LAS unsigned*)(F.lds + MISC_OFF);
    F.tid = threadIdx.x; F.lane = F.tid & 63; F.wave = __builtin_amdgcn_readfirstlane(F.tid >> 6);
    F.G = gridDim.x; { const int bx = blockIdx.x; F.vcu = (F.G % 8 == 0) ? (bx % 8) * (F.G / 8) + bx / 8 : bx; }
    F.ctl = (gu32*)(args.ws + WS_CTL);
    for (int u = F.tid; u < (LDS_BYTES - LDSCTL_OFF) / 4; u += NWAVES * 64) ((LAS unsigned*)(F.lds + LDSCTL_OFF))[u] = 0u;
    __syncthreads();
    XcdBarrier bar = xcd_barrier_post((unsigned*)(F.ctl + CW_BAR), F.MISC + 8);

#if PH_HI > 0
    {
        PHASE_BEGIN();
        float* cosd = WSP(float, TAB_COSD); float* sind = WSP(float, TAB_SIND); float* cosr = WSP(float, TAB_COSR); float* sinr = WSP(float, TAB_SINR);
        for (int e = gt; e < 8192 * 40; e += NGT) { const int pos = e / 40, f = e % 40; float s, c;
            if (f < 8) { sincos_d((double)pos * INV_D[f], s, c); cosd[pos * 8 + f] = c; sind[pos * 8 + f] = s; }
            else { sincos_d((double)pos * INV_R[f - 8], s, c); cosr[pos * 32 + f - 8] = c; sinr[pos * 32 + f - 8] = s; } }
        LAS float* scr = (LAS float*)(F.lds + RING_OFF + F.wave * 16384);
        constexpr int I_IN = (DM / 64) * (NIN / 32), I_OUT = (DM / 64) * (DM / 32), I_UP = (DM / 64) * (NUP / 32), I_DN = (DFF / 64) * (DM / 32);
        for (int it = gw; it < I_IN + I_OUT + I_UP + I_DN; it += NGW) {
            int r = it;
            if (r < I_IN) { p0_transpose_item<1>(args.in[7], DM, NIN, WSP(bf16, WS_WIN), nullptr, scr, r, F.lane); continue; } r -= I_IN;
            if (r < I_OUT) { p0_transpose_item<0>(args.in[10], DM, DM, WSP(bf16, WS_WOUT), nullptr, scr, r, F.lane); continue; } r -= I_OUT;
            if (r < I_UP) { p0_transpose_item<2>(args.in[12], DM, NUP, WSP(bf16, WS_WUP), args.in[11], scr, r, F.lane); continue; } r -= I_UP;
            p0_transpose_item<0>(args.in[13], DFF, DM, WSP(bf16, WS_WDN), nullptr, scr, r, F.lane);
        }
        const float* x_prompt = args.in[0]; const float* x_sample = args.in[1]; bf16* XN = WSP(bf16, WS_XN);
        for (int m = gw; m < MT; m += NGW) rms_row_to_bf16(F.lane, m < MP ? x_prompt + (size_t)m * DM : x_sample + (size_t)(m - MP) * DM, args.in[6], XN + (size_t)m * DM);
        xcd_barrier(bar);
    }
#endif
#if PH_HI > 1
    {
        PHASE_BEGIN();
        pg8::Gemm g{WSP(bf16, WS_XN), WSP(bf16, WS_WIN), MT, NIN, DM}; pg8::StaticOrder S; S.init(MT, NIN, F.G, (int)blockIdx.x);
        pg8::EpiInProj E{WSP(bf16, WS_DQ), WSP(bf16, WS_DK), WSP(bf16, WS_DV), WSP(bf16, WS_RQ), WSP(bf16, WS_RK), WSP(bf16, WS_RV), WSP(bf16, WS_RG), out,
                         WSP(float, TAB_COSD), WSP(float, TAB_SIND), WSP(float, TAB_COSR), WSP(float, TAB_SINR)};
        pg8::gemm_phase<pg8::EpiInProj, pg8::StaticOrder, true, true>(F.lds + RING_OFF, g, S, E);
        xcd_barrier(bar);
    }
#endif
#if PH_HI > 2
    {
        PHASE_BEGIN();
        for (int vv = F.vcu; vv < 256; vv += F.G) {
            const int hm = (vv >> 4) & 15, s = vv & 15, b = hm >> 3, h = (hm >> 1) & 3, m = hm & 1;
            bf16* DQ = WSP(bf16, WS_DQ); bf16* DK = WSP(bf16, WS_DK); bf16* DV = WSP(bf16, WS_DV); bf16* OA = WSP(bf16, WS_OA);
            att::BlockRef r0, r1;
            const size_t rb = (size_t)b * SEQ;
            r0.Q = DQ + (rb + (size_t)s * 256) * 512 + (h * 2 + m) * 64; r0.K = DK + rb * 512 + (h * 2 + m) * 64; r0.V = DV + rb * 512 + h * 128;
            r0.O = OA + (rb + (size_t)s * 256) * 1024 + (h * 2 + m) * 128; r0.P0 = s * 256;
            r1 = r0; r1.Q = DQ + (rb + (size_t)(31 - s) * 256) * 512 + (h * 2 + m) * 64; r1.O = OA + (rb + (size_t)(31 - s) * 256) * 1024 + (h * 2 + m) * 128; r1.P0 = (31 - s) * 256;
            att::Seam S;
            att::attn_prime(r0, (char*)lds + RING_OFF, S);
            att::attn_block(r0, r1, (char*)lds + RING_OFF, S);
            att::attn_block(r1, r1, (char*)lds + RING_OFF, S);
        }
        VM_WAIT(); __syncthreads();
    }
    {
        PHASE_BEGIN();
        LAS float* scr = (LAS float*)(F.lds + RING_OFF) + F.wave * 1024;
        const float* cache_k = args.in[2]; const float* cache_v = args.in[3]; const int* page_table = (const int*)args.in[5];
        for (int it = gw; it < DEC_B * N_ITEMS; it += NGW) {
            int db, pg; if (it < DEC_B * N_PAGES) { db = it >> 4; pg = it & 15; } else { db = it - DEC_B * N_PAGES; pg = N_PAGES; }
            const float* Kb; const float* Vb; int ntok;
            if (pg < N_PAGES) { const int phys = __builtin_amdgcn_readfirstlane(page_table[db * N_PAGES + pg]); Kb = cache_k + (size_t)phys * PAGE * 512; Vb = cache_v + (size_t)phys * PAGE * 512; ntok = PAGE; }
            else { Kb = out + pg8::OFF_KS + (size_t)db * 4 * 512; Vb = out + pg8::OFF_VS + (size_t)db * 4 * 512; ntok = DEC_T; }
            const int item = db * N_ITEMS + pg;
            decode_item(Kb, Vb, ntok, pg == N_PAGES, WSP(bf16, WS_DQ) + (size_t)(MP + db * 4) * 512, scr, WSP(float, WS_DECO) + (size_t)item * 4096, WSP(float, WS_DECML) + (size_t)item * 64, F.lane);
        }
        __syncthreads();
    }
    {
        PHASE_BEGIN();
        for (int u = F.vcu; u < 512; u += F.G) ret_kv_unit(F, u >> 6, u & 63, WSP(bf16, WS_RK), WSP(bf16, WS_RV), WSP(float, WS_KV));
        for (int it = gw; it < DEC_B * 4; it += NGW) sample_ret_item(it >> 2, it & 3, F.lane, WSP(bf16, WS_RQ), WSP(bf16, WS_RK), WSP(bf16, WS_RV), WSP(bf16, WS_RG), args.in[4], out + pg8::OFF_RS, WSP(bf16, WS_CAT));
        xcd_barrier(bar);
    }
#endif
#if PH_HI > 3
    {
        PHASE_BEGIN();
        { float* KV = WSP(float, WS_KV); bf16* ST = WSP(bf16, WS_ST);
        for (int e = gt; e < 8 * 8192; e += NGT) { const int bh = e >> 13, idx = e & 8191, h = bh & 3; const float gc = __builtin_amdgcn_exp2f(log2_gamma(h) * 128.f);
            float s = 0.f; const float* kv = KV + (size_t)bh * 64 * 8192 + idx; bf16* st = ST + (size_t)bh * 64 * 8192 + idx;
#pragma unroll 8
            for (int c = 0; c < 64; ++c) { st[(size_t)c * 8192] = (bf16)f2bf(s); s = s * gc + kv[(size_t)c * 8192]; }
            const int ee = idx >> 6, d = idx & 63; out[pg8::OFF_RP + (size_t)bh * 8192 + d * 128 + ee] = s; } }
        const float* diff_lambda = args.in[8]; const float* subln_g = args.in[9];
        bf16* OA = WSP(bf16, WS_OA); bf16* CAT = WSP(bf16, WS_CAT); float* DECO = WSP(float, WS_DECO); float* DECML = WSP(float, WS_DECML);
        float lam;
        { const float a = diff_lambda[F.lane] * diff_lambda[64 + F.lane], bq = diff_lambda[128 + F.lane] * diff_lambda[192 + F.lane];
          lam = __expf(wave_sum(a)) - __expf(wave_sum(bq)) + 0.2f; }
        const int hh = F.lane >> 4, ch = F.lane & 15;
        f32x4 sg0 = *(const f32x4*)(subln_g + ch * 8), sg1 = *(const f32x4*)(subln_g + ch * 8 + 4);
        for (int row = gw; row < MP; row += NGW) {
            const v4u a = *(const GAS v4u*)(OA + (size_t)row * 1024 + (hh * 2) * 128 + ch * 8), bq = *(const GAS v4u*)(OA + (size_t)row * 1024 + (hh * 2 + 1) * 128 + ch * 8);
            float d[8]; const unsigned aw[4] = {a.x, a.y, a.z, a.w}, bw[4] = {bq.x, bq.y, bq.z, bq.w}; float ss = 0.f;
#pragma unroll
            for (int q = 0; q < 4; ++q) { d[2 * q] = bflo(aw[q]) - lam * bflo(bw[q]); d[2 * q + 1] = bfhi(aw[q]) - lam * bfhi(bw[q]); ss += d[2 * q] * d[2 * q] + d[2 * q + 1] * d[2 * q + 1]; }
            ss += __shfl_xor(ss, 1); ss += __shfl_xor(ss, 2); ss += __shfl_xor(ss, 4); ss += __shfl_xor(ss, 8);
            const float r = 0.8f / sqrtf(ss * (1.f / 128.f) + 1e-5f);
            v4u o; o.x = pk2(d[0] * r * sg0[0], d[1] * r * sg0[1]); o.y = pk2(d[2] * r * sg0[2], d[3] * r * sg0[3]); o.z = pk2(d[4] * r * sg1[0], d[5] * r * sg1[1]); o.w = pk2(d[6] * r * sg1[2], d[7] * r * sg1[3]);
            *(GAS v4u*)(CAT + (size_t)row * 1024 + hh * 128 + ch * 8) = o;
        }
        for (int it = gw; it < MS * 4; it += NGW) {
            typedef float f32x2 __attribute__((ext_vector_type(2)));
            const int srow = it >> 2, h = it & 3, db = srow >> 2, tq = srow & 3; f32x2 om[2];
#pragma unroll
            for (int m = 0; m < 2; ++m) { const int r = (h * 2 + m) * 4 + tq; float M = -1e30f;
                for (int pgi = 0; pgi < N_ITEMS; ++pgi) M = fmaxf(M, DECML[(size_t)(db * N_ITEMS + pgi) * 64 + r * 2]);
                float L = 0.f; f32x2 acc = (f32x2){0.f, 0.f};
                for (int pgi = 0; pgi < N_ITEMS; ++pgi) { const size_t item = (size_t)(db * N_ITEMS + pgi); const float w = __builtin_amdgcn_exp2f(DECML[item * 64 + r * 2] - M);
                    L += w * DECML[item * 64 + r * 2 + 1]; acc += *(const f32x2*)(DECO + item * 4096 + r * 128 + 2 * F.lane) * w; }
                om[m] = acc * (1.f / L); }
            const f32x2 dd = om[0] - om[1] * lam;
            const float ss = wave_sum(dd.x * dd.x + dd.y * dd.y); const float r = 0.8f / sqrtf(ss * (1.f / 128.f) + 1e-5f);
            *(GAS unsigned*)(CAT + (size_t)(MP + srow) * 1024 + h * 128 + 2 * F.lane) = pk2(dd.x * r * subln_g[2 * F.lane], dd.y * r * subln_g[2 * F.lane + 1]);
        }
        xcd_barrier(bar);
    }
#endif
#if PH_HI > 4
    {
        PHASE_BEGIN();
        for (int u = F.vcu; u < 512; u += F.G) ret_out_unit(F, u >> 6, u & 63, WSP(bf16, WS_RQ), WSP(bf16, WS_RK), WSP(bf16, WS_RV), WSP(bf16, WS_RG), WSP(bf16, WS_ST), WSP(bf16, WS_CAT));
        xcd_barrier(bar);
    }
#endif
#if PH_HI > 5
    {
        PHASE_BEGIN();
        pg8::Gemm g{WSP(bf16, WS_CAT), WSP(bf16, WS_WOUT), MT, DM, DM}; pg8::StaticOrder S; S.init(MT, DM, F.G, (int)blockIdx.x);
        pg8::EpiOutProj E{args.in[0], args.in[1], WSP(float, WS_X1), WSP(bf16, WS_X1B), WSP(float, WS_SSQ)};
        pg8::gemm_phase<pg8::EpiOutProj, pg8::StaticOrder, true, true>(F.lds + RING_OFF, g, S, E);
        xcd_barrier(bar);
    }
#endif
#if PH_HI > 6
    {
        PHASE_BEGIN();
        pg8::Gemm g{WSP(bf16, WS_X1B), WSP(bf16, WS_WUP), MT, NUP, DM}; pg8::StaticOrder S; S.init(MT, NUP, F.G, (int)blockIdx.x);
        pg8::EpiUp E{WSP(bf16, WS_H), WSP(float, WS_SSQ)};
        pg8::gemm_phase<pg8::EpiUp, pg8::StaticOrder, true, true>(F.lds + RING_OFF, g, S, E);
        xcd_barrier(bar);
    }
#endif
#if PH_HI > 7
    {
        PHASE_BEGIN();
        pg8::Gemm g{WSP(bf16, WS_H), WSP(bf16, WS_WDN), MT, DM, DFF}; pg8::StaticOrder S; S.init(MT, DM, F.G, (int)blockIdx.x);
        pg8::EpiDown E{WSP(float, WS_X1), out + pg8::OFF_Y};
        pg8::gemm_phase<pg8::EpiDown, pg8::StaticOrder, true, true>(F.lds + RING_OFF, g, S, E);
        xcd_barrier(bar);
    }
#endif
#if PH_HI > 8
    {
        PHASE_BEGIN();
        const float* norm_final_g = args.in[14];
        for (int m = gw; m < MT; m += NGW) { float* yr = out + pg8::OFF_Y + (size_t)m * DM;
            GAS f32x4* xr = (GAS f32x4*)yr + F.lane; const GAS f32x4* gr = (const GAS f32x4*)norm_final_g + F.lane;
            f32x4 v[4]; float s = 0.f;
#pragma unroll
            for (int j = 0; j < 4; ++j) { v[j] = xr[64 * j]; s += (v[j].x * v[j].x + v[j].y * v[j].y) + (v[j].z * v[j].z + v[j].w * v[j].w); }
            const float r = 1.f / sqrtf(wave_sum(s) * (1.f / DM) + 1e-6f);
#pragma unroll
            for (int j = 0; j < 4; ++j) xr[64 * j] = v[j] * r * gr[64 * j]; }
    }
#endif
}

extern "C" void kernel_launch(void* const* d_in, const int* in_sizes, int n_in, void* d_out, int out_size, void* d_ws, size_t ws_size, hipStream_t stream) {
    static int grid = 0;
    if (grid == 0) {
        if (n_in != 15 || ws_size < WS_END) { fprintf(stderr, "kernel_launch: unexpected inputs (n_in %d, ws %zu)\n", n_in, ws_size); grid = -1; return; }
        int dev = 0, cus = 0, per_cu = 0;
        if (hipGetDevice(&dev) != hipSuccess || hipDeviceGetAttribute(&cus, hipDeviceAttributeMultiprocessorCount, dev) != hipSuccess) { grid = -1; return; }
        if (hipFuncSetAttribute((const void*)hymba_fwd, hipFuncAttributeMaxDynamicSharedMemorySize, LDS_BYTES) != hipSuccess) { fprintf(stderr, "kernel_launch: hipFuncSetAttribute failed\n"); grid = -1; return; }
        if (hipOccupancyMaxActiveBlocksPerMultiprocessor(&per_cu, (const void*)hymba_fwd, NWAVES * 64, LDS_BYTES) != hipSuccess || per_cu < 1) fprintf(stderr, "kernel_launch: occupancy query reports %d\n", per_cu);
        (void)hipGetLastError();
        grid = cus;
    }
    if (grid < 0) return;
    if (hipMemsetAsync((char*)d_ws + WS_CTL, 0, CTL_ZERO_BYTES, stream) != hipSuccess) return;
    Args a{};
    for (int i = 0; i < 15; ++i) a.in[i] = (const float*)d_in[i];
    a.out = (float*)d_out; a.ws = (unsigned char*)d_ws;
    hipLaunchKernelGGL(hymba_fwd, dim3(grid), dim3(NWAVES * 64), LDS_BYTES, stream, a);
}
```

```cpp
#include <hip/hip_runtime.h>
#include <cstdio>
#include <cstdint>
#ifndef PH_HI
#define PH_HI 9
#endif
#ifndef REP_P1
#define REP_P1 1
#endif
#ifndef REP_P2A
#define REP_P2A 1
#endif
#ifndef REP_P2B
#define REP_P2B 1
#endif
#ifndef REP_P5
#define REP_P5 1
#endif
#ifndef REP_P6
#define REP_P6 1
#endif
#ifndef REP_P7
#define REP_P7 1
#endif
#ifndef REP_P0
#define REP_P0 1
#endif
#ifndef REP_P2C
#define REP_P2C 1
#endif
#ifndef REP_P3
#define REP_P3 1
#endif
#ifndef REP_P4
#define REP_P4 1
#endif
namespace pg8 {
#define PG8_LAS __attribute__((address_space(3)))
typedef unsigned short bf16_t;
typedef short bf16x8 __attribute__((ext_vector_type(8)));
typedef float f32x4 __attribute__((ext_vector_type(4)));
typedef unsigned u32x4 __attribute__((ext_vector_type(4)));
constexpr int BM = 256, BK = 64, HALF = 128, HTB = HALF * BK * 2  , STAGE_BYTES = 8 * HTB, NXCD = 8, WGM = 8;

__host__ __device__ __forceinline__ int lds_byte(int r, int c) { const int st = (r >> 4) * 2 + (c >> 5), rr = r & 15, cc = c & 31, ob = rr * 64 + cc * 2; return st * 1024 + (ob ^ (((ob >> 9) & 1) << 5)); }
__host__ __device__ __forceinline__ void stage_rc(int b, int& R, int& C) { const int st = b / 1024, sb = b % 1024, swz = sb ^ (((sb >> 9) & 1) << 5); R = (st >> 1) * 16 + swz / 64; C = (st & 1) * 32 + (swz % 64) / 2; }
__host__ __device__ __forceinline__ int perm32(int rho) { const int n = rho >> 4, i = rho & 15; return 8 * (i >> 2) + 4 * n + (i & 3); }

struct Unit { int pm, pn; };
struct Gemm { const bf16_t* A; const bf16_t* Bt; int M, N, K; };

struct StaticOrder {
    int nM, nN, nwg, G, c;
    __host__ __device__ void init(int M, int N, int G_, int c_) { nM = M / BM; nN = N / BM; nwg = nM * nN; G = G_; c = c_; }
    __host__ __device__ bool next(int i, Unit& u) const {
        const long L = (long)i * G + c; if (L >= nwg) return false;
        int wgid = (int)L; { const int q = nwg / NXCD, r = nwg % NXCD, xcd = wgid % NXCD, off = wgid / NXCD; wgid = (xcd < r ? xcd * (q + 1) : r * (q + 1) + (xcd - r) * q) + off; }
        const int nig = WGM * nN, gid = wgid / nig, fm = gid * WGM, gsz = (nM - fm) < WGM ? (nM - fm) : WGM;
        u.pm = fm + ((wgid % nig) % gsz); u.pn = (wgid % nig) / gsz; return true;
    }
    __device__ __forceinline__ void a_ready(const Unit&) const {}
    __device__ __forceinline__ void done(const Unit&) const {}
};

__device__ __forceinline__ unsigned cvt_pk_bf16(float lo, float hi) { unsigned r; asm volatile("v_cvt_pk_bf16_f32 %0, %1, %2" : "=v"(r) : "v"(lo), "v"(hi)); return r; }
typedef float f32x2 __attribute__((ext_vector_type(2)));
typedef unsigned u32x2 __attribute__((ext_vector_type(2)));
constexpr int MP = 16384, MS = 512, MT = MP + MS;
constexpr long OFF_Y = 0, OFF_KP = 17301504, OFF_VP = 25690112, OFF_RP = 34078720, OFF_KS = 34144256, OFF_VS = 34406400, OFF_RS = 34668544;
__device__ __forceinline__ void st4bf(bf16_t* p, f32x4 v) { u32x2 w; w.x = cvt_pk_bf16(v[0], v[1]); w.y = cvt_pk_bf16(v[2], v[3]); *(u32x2*)p = w; }
__device__ __forceinline__ void st8bf(bf16_t* p, f32x4 a, f32x4 b) { u32x4 w; w.x = cvt_pk_bf16(a[0], a[1]); w.y = cvt_pk_bf16(a[2], a[3]); w.z = cvt_pk_bf16(b[0], b[1]); w.w = cvt_pk_bf16(b[2], b[3]); *(u32x4*)p = w; }
__device__ __forceinline__ float silu1(float x) { return x * __builtin_amdgcn_rcpf(1.f + __builtin_amdgcn_exp2f(-1.4426950408889634f * x)); }
__device__ __forceinline__ f32x4 silu4(f32x4 v) { return (f32x4){silu1(v[0]), silu1(v[1]), silu1(v[2]), silu1(v[3])}; }

struct EpiInProj {
    static constexpr bool PERM = true, AFTER_DRAIN = false;
    bf16_t *DQ, *DK, *DV, *RQ, *RK, *RV, *RG; float* out; const float *cosd, *sind, *cosr, *sinr;
    __device__ __forceinline__ void elem(int row, int gc, const f32x4 v0, const f32x4 v1) const {
        const int pn = gc >> 8; const bool smp = row >= MP;
        const int pos = smp ? 2048 + ((row - MP) & 3) : (row & 8191);
        if (pn < 4) {
            const int lc = gc & 511, d8 = lc & 63; const bool isk = pn >= 2;
            bf16_t* dst = (isk ? DK : DQ) + (size_t)row * 512;
            float* kout = (smp ? out + OFF_KS - (long)MP * 512 : out + OFF_KP) + (size_t)row * 512;
            if (d8 < 16) {
                const int i0 = (d8 >> 3) * 4, c1 = (lc & ~63) + i0, c2 = c1 + 8;
                const f32x4 cs = *(const f32x4*)(cosd + pos * 8 + i0), sn = *(const f32x4*)(sind + pos * 8 + i0);
                const f32x4 o1 = v0 * cs - v1 * sn, o2 = v1 * cs + v0 * sn;
                st4bf(dst + c1, o1); st4bf(dst + c2, o2);
                if (isk) { *(f32x4*)(kout + c1) = o1; *(f32x4*)(kout + c2) = o2; }
            } else {
                st8bf(dst + lc, v0, v1);
                if (isk) { *(f32x4*)(kout + lc) = v0; *(f32x4*)(kout + lc + 4) = v1; }
            }
        } else if (pn < 6) {
            const int lc = gc - 1024;
            float* vout = (smp ? out + OFF_VS - (long)MP * 512 : out + OFF_VP) + (size_t)row * 512;
            st8bf(DV + (size_t)row * 512 + lc, v0, v1);
            *(f32x4*)(vout + lc) = v0; *(f32x4*)(vout + lc + 4) = v1;
        } else if (pn < 8) {
            const int lc = gc - (pn == 6 ? 1536 : 1792), d8 = lc & 63, i0 = (d8 >> 3) * 4, c1 = (lc & ~63) + i0, c2 = c1 + 32;
            const f32x4 cs = *(const f32x4*)(cosr + pos * 32 + i0), sn = *(const f32x4*)(sinr + pos * 32 + i0);
            f32x4 o1 = v0 * cs - v1 * sn, o2 = v1 * cs + v0 * sn;
            bf16_t* dst = (pn == 6 ? RQ : RK) + (size_t)row * 256;
            if (pn == 7) { o1 = o1 * 0.125f; o2 = o2 * 0.125f; }
            st4bf(dst + c1, o1); st4bf(dst + c2, o2);
        } else if (pn < 10) {
            st8bf(RV + (size_t)row * 512 + (gc - 2048), v0, v1);
        } else {
            st8bf(RG + (size_t)row * 512 + (gc - 2560), silu4(v0), silu4(v1));
        }
    }
    __device__ __forceinline__ void skinny(int row, int gc, const f32x4 v0, const f32x4 v1) const { elem(row, gc, v0, v1); }
    __device__ __forceinline__ void operator()(const f32x4 (&acc)[2][2][4][2], const Unit& u, int wr, int wc, int fr, int fq) const {
        const int rowt = u.pm * BM + wr * 64 + fr, colt = u.pn * 256 + wc * 32 + 8 * fq;
#pragma unroll
        for (int ai = 0; ai < 2; ++ai)
#pragma unroll
            for (int m = 0; m < 4; ++m)
#pragma unroll
                for (int bj = 0; bj < 2; ++bj) elem(rowt + ai * HALF + m * 16, colt + bj * 128, acc[ai][bj][m][0], acc[ai][bj][m][1]);
    }
};
struct EpiOutProj {
    static constexpr bool PERM = true, AFTER_DRAIN = false;
    const float* xp; const float* xs; bf16_t* X1B; float* SSQ;
    __device__ __forceinline__ float elem(int row, int gc, const f32x4 a0, const f32x4 a1) const {
        const float* xb = (row >= MP) ? xs - (long)MP * 1024 : xp;
        const size_t off = (size_t)row * 1024 + gc;
        const f32x4 v0 = a0 + *(const f32x4*)(xb + off), v1 = a1 + *(const f32x4*)(xb + off + 4);
        st8bf(X1B + off, v0, v1);
        return (v0[0] * v0[0] + v0[1] * v0[1]) + (v0[2] * v0[2] + v0[3] * v0[3]) + (v1[0] * v1[0] + v1[1] * v1[1]) + (v1[2] * v1[2] + v1[3] * v1[3]);
    }
    __device__ __forceinline__ void skinny(int row, int gc, const f32x4 v0, const f32x4 v1) const {
        float ss = elem(row, gc, v0, v1); ss += __shfl_xor(ss, 16); ss += __shfl_xor(ss, 32);
        if ((threadIdx.x & 48) == 0) SSQ[(size_t)row * 32 + (gc >> 5)] = ss;
    }
    __device__ __forceinline__ void operator()(const f32x4 (&acc)[2][2][4][2], const Unit& u, int wr, int wc, int fr, int fq) const {
        const int rowt = u.pm * BM + wr * 64 + fr, colt = u.pn * BM + wc * 32 + 8 * fq;
#pragma unroll
        for (int ai = 0; ai < 2; ++ai)
#pragma unroll
            for (int m = 0; m < 4; ++m)
#pragma unroll
                for (int bj = 0; bj < 2; ++bj) { const int row = rowt + ai * HALF + m * 16;
                    float ss = elem(row, colt + bj * HALF, acc[ai][bj][m][0], acc[ai][bj][m][1]); ss += __shfl_xor(ss, 16); ss += __shfl_xor(ss, 32);
                    if (fq == 0) SSQ[(size_t)row * 32 + u.pn * 8 + bj * 4 + wc] = ss; }
    }
};
struct EpiUp {
    static constexpr bool PERM = true, AFTER_DRAIN = false;
    bf16_t* H; const float* SSQ;
    __device__ __forceinline__ void operator()(const f32x4 (&acc)[2][2][4][2], const Unit& u, int wr, int wc, int fr, int fq) const {
        const int rowt = u.pm * BM + wr * 64 + fr, colt = u.pn * BM + wc * 32 + 8 * fq;
#pragma unroll
        for (int ai = 0; ai < 2; ++ai)
#pragma unroll
            for (int m = 0; m < 4; ++m) {
                const int row = rowt + ai * HALF + m * 16;
                const f32x4* sp = (const f32x4*)(SSQ + (size_t)row * 32 + 8 * fq);
                const f32x4 sa = sp[0] + sp[1];
                float tot = (sa[0] + sa[1]) + (sa[2] + sa[3]); tot += __shfl_xor(tot, 16); tot += __shfl_xor(tot, 32);
                const float r = 1.0f / sqrtf(tot * (1.0f / 1024.0f) + 1e-6f);
#pragma unroll
                for (int bj = 0; bj < 2; ++bj) {
                    const int f0 = (colt + bj * HALF) >> 1;
                    const f32x4 g = acc[ai][bj][m][0] * r, uu = acc[ai][bj][m][1] * r;
                    st4bf(H + (size_t)row * 2816 + f0, silu4(g) * uu);
                }
            }
    }
};
struct EpiDown {
    static constexpr bool PERM = true, AFTER_DRAIN = false;
    const bf16_t* X1B; float* Y;
    __device__ __forceinline__ void elem(int row, int gc, const f32x4 a0, const f32x4 a1) const {
        const size_t off = (size_t)row * 1024 + gc;
        const u32x4 w = *(const u32x4*)(X1B + off);
        const f32x4 r0 = (f32x4){__uint_as_float(w.x << 16), __uint_as_float(w.x & 0xffff0000u), __uint_as_float(w.y << 16), __uint_as_float(w.y & 0xffff0000u)};
        const f32x4 r1 = (f32x4){__uint_as_float(w.z << 16), __uint_as_float(w.z & 0xffff0000u), __uint_as_float(w.w << 16), __uint_as_float(w.w & 0xffff0000u)};
        *(f32x4*)(Y + off) = a0 + r0; *(f32x4*)(Y + off + 4) = a1 + r1;
    }
    __device__ __forceinline__ void skinny(int row, int gc, const f32x4 v0, const f32x4 v1) const { elem(row, gc, v0, v1); }
    __device__ __forceinline__ void operator()(const f32x4 (&acc)[2][2][4][2], const Unit& u, int wr, int wc, int fr, int fq) const {
        const int rowt = u.pm * BM + wr * 64 + fr, colt = u.pn * BM + wc * 32 + 8 * fq;
#pragma unroll
        for (int ai = 0; ai < 2; ++ai)
#pragma unroll
            for (int m = 0; m < 4; ++m)
#pragma unroll
                for (int bj = 0; bj < 2; ++bj) elem(rowt + ai * HALF + m * 16, colt + bj * HALF, acc[ai][bj][m][0], acc[ai][bj][m][1]);
    }
};
template <class Epi>
__device__ __forceinline__ void skinny_phase(const bf16_t* A  , const bf16_t* Bt, int K, int N, int row0, const Epi& E, int vcu, int G) {
    int tid_l = threadIdx.x; asm volatile("" : "+v"(tid_l));
    const int wid = __builtin_amdgcn_readfirstlane(tid_l >> 6), lane = tid_l & 63, fr = lane & 15, fq = lane >> 4;
    for (int wt = wid * G + vcu; wt < N; wt += 8 * G) {
        const int tg = wt & 31, cg = wt >> 5;
        const bf16_t* ap = A + (size_t)(16 * tg + fr) * K + 8 * fq;
        const bf16_t* b0 = Bt + (size_t)(32 * cg + perm32(fr)) * K + 8 * fq;
        const bf16_t* b1 = Bt + (size_t)(32 * cg + perm32(16 + fr)) * K + 8 * fq;
        f32x4 acc0 = (f32x4){0.f, 0.f, 0.f, 0.f}, acc1 = (f32x4){0.f, 0.f, 0.f, 0.f};
        for (int kb = 0; kb < K / 32; kb += 8) {
            bf16x8 a[8], x0[8], x1[8];
#pragma unroll
            for (int q = 0; q < 8; ++q) { a[q] = *(const bf16x8*)(ap + 32 * (kb + q)); x0[q] = *(const bf16x8*)(b0 + 32 * (kb + q)); x1[q] = *(const bf16x8*)(b1 + 32 * (kb + q)); }
#pragma unroll
            for (int q = 0; q < 8; ++q) { acc0 = __builtin_amdgcn_mfma_f32_16x16x32_bf16(x0[q], a[q], acc0, 0, 0, 0); acc1 = __builtin_amdgcn_mfma_f32_16x16x32_bf16(x1[q], a[q], acc1, 0, 0, 0); }
        }
        E.skinny(row0 + 16 * tg + fr, 32 * cg + 8 * fq, acc0, acc1);
    }
}
template <class Epi, class Sched, bool ALIGN_EPI = false, bool SP2 = false>
__device__ __forceinline__ void gemm_phase(PG8_LAS unsigned char* lds, const Gemm g, const Sched& S, const Epi& E) {
    int tid_l = threadIdx.x; asm volatile("" : "+v"(tid_l));
    const int tid = tid_l, wid = __builtin_amdgcn_readfirstlane(tid >> 6), lane = tid & 63, wr = wid >> 2, wc = wid & 3, fr = lane & 15, fq = lane >> 4;
    const int K = g.K, nt = K / BK;
    unsigned voffA[2], voffB[2];
#pragma unroll
    for (int i = 0; i < 2; ++i) { int R, C; stage_rc(tid * 16 + i * 8192, R, C); const int Rb = Epi::PERM ? ((R & ~31) + perm32(R & 31)) : R;
        voffA[i] = (unsigned)(R * K + C) * 2u; voffB[i] = (unsigned)(Rb * K + C) * 2u; }
    const size_t kstep = (size_t)(BK * 2);
    const size_t hstep = (size_t)HALF * K * 2;
    const size_t tstep = 2 * hstep;
    const unsigned ldsw = (unsigned)wid * 1024u;
    const int aoff = lds_byte(wr * 64 + fr, fq * 8), boff = lds_byte(wc * 32 + fr, fq * 8);
#define PG8_SA(b, h) (((b) * 2 + (h)) * HTB)
#define PG8_SB(b, h) ((4 + (b) * 2 + (h)) * HTB)
#define PG8_STAGE(bufoff, gbase, voff) do { _Pragma("unroll") for (int _i = 0; _i < 2; ++_i) \
        __builtin_amdgcn_global_load_lds((const unsigned*)((const char*)(gbase) + (voff)[_i]), (PG8_LAS unsigned*)(lds + (bufoff) + ldsw + _i * 8192), 16, 0, 0); } while (0)
#define PG8_LDA(dst, b, h) do { _Pragma("unroll") for (int m = 0; m < 4; ++m) _Pragma("unroll") for (int k = 0; k < 2; ++k) dst[m][k] = *(const PG8_LAS bf16x8*)(lds + PG8_SA(b, h) + aoff + m * 2048 + k * 1024); } while (0)
#define PG8_LDB(dst, b, h) do { _Pragma("unroll") for (int n = 0; n < 2; ++n) _Pragma("unroll") for (int k = 0; k < 2; ++k) dst[n][k] = *(const PG8_LAS bf16x8*)(lds + PG8_SB(b, h) + boff + n * 2048 + k * 1024); } while (0)
#define PG8_MMA(ai, bj, At, Bt) do { __builtin_amdgcn_s_setprio(1); _Pragma("unroll") for (int m = 0; m < 4; ++m) _Pragma("unroll") for (int n = 0; n < 2; ++n) _Pragma("unroll") for (int k = 0; k < 2; ++k) \
        acc[ai][bj][m][n] = __builtin_amdgcn_mfma_f32_16x16x32_bf16(Bt[n][k], At[m][k], acc[ai][bj][m][n], 0, 0, 0); __builtin_amdgcn_s_setprio(0); } while (0)
#define PG8_WAIT_V(n) asm volatile("s_waitcnt vmcnt(" #n ")" ::: "memory")
#define PG8_WAIT_L(n) asm volatile("s_waitcnt lgkmcnt(" #n ")" ::: "memory")
#define PG8_BAR __builtin_amdgcn_s_barrier()
#define PG8_SCHED __builtin_amdgcn_sched_barrier(0)
    Unit cur, nxt; int ui = 0;
    if (!S.next(0, cur)) return;
    f32x4 acc[2][2][4][2];
#pragma unroll
    for (int a = 0; a < 2; ++a)
#pragma unroll
        for (int b = 0; b < 2; ++b)
#pragma unroll
            for (int m = 0; m < 4; ++m)
#pragma unroll
                for (int n = 0; n < 2; ++n) acc[a][b][m][n] = (f32x4){0.f, 0.f, 0.f, 0.f};
    bf16x8 At[4][2], B0[2][2], B1[2][2];
    const char* cA = (const char*)g.A + (size_t)cur.pm * tstep; const char* cB = (const char*)g.Bt + (size_t)cur.pn * tstep;
    S.a_ready(cur);
    if constexpr (SP2) {
        PG8_STAGE(PG8_SB(0, 0), cB, voffB); PG8_STAGE(PG8_SB(0, 1), cB + hstep, voffB); PG8_STAGE(PG8_SA(0, 0), cA, voffA); PG8_STAGE(PG8_SA(0, 1), cA + hstep, voffA);
        if (wr == 1) PG8_BAR;
        PG8_WAIT_V(2); PG8_BAR;
        PG8_STAGE(PG8_SB(1, 0), cB + kstep, voffB); PG8_STAGE(PG8_SA(1, 0), cA + kstep, voffA); PG8_STAGE(PG8_SB(1, 1), cB + hstep + kstep, voffB);
        PG8_WAIT_V(6); PG8_BAR;
    } else {
        PG8_STAGE(PG8_SB(0, 0), cB, voffB); PG8_STAGE(PG8_SA(0, 0), cA, voffA); PG8_STAGE(PG8_SB(0, 1), cB + hstep, voffB); PG8_STAGE(PG8_SA(0, 1), cA + hstep, voffA);
        if (wr == 1) PG8_BAR;
        PG8_WAIT_V(4); PG8_BAR;
        PG8_STAGE(PG8_SB(1, 0), cB + kstep, voffB); PG8_STAGE(PG8_SA(1, 0), cA + kstep, voffA); PG8_STAGE(PG8_SB(1, 1), cB + hstep + kstep, voffB);
        PG8_WAIT_V(6); PG8_BAR;
    }
    for (;;) {
        const bool has_next = S.next(ui + 1, nxt);
        const char* nA = has_next ? (const char*)g.A + (size_t)nxt.pm * tstep : cA; const char* nB = has_next ? (const char*)g.Bt + (size_t)nxt.pn * tstep : cB;
        for (int t = 0; t < nt; t += 2) {
            const bool last = (t == nt - 2);
            const char* a1 = cA + (size_t)(t + 1) * kstep;
            const char* a2 = last ? nA : cA + (size_t)(t + 2) * kstep; const char* b2 = last ? nB : cB + (size_t)(t + 2) * kstep;
            const char* a3 = a2 + kstep; const char* b3 = b2 + kstep;
            if (last && has_next) S.a_ready(nxt);
            if constexpr (SP2) {
            PG8_LDB(B0, 0, 0); PG8_LDB(B1, 0, 1); PG8_SCHED; PG8_LDA(At, 0, 0); PG8_STAGE(PG8_SA(1, 1), a1 + hstep, voffA);
            PG8_WAIT_V(8); PG8_WAIT_L(0); PG8_BAR; PG8_MMA(0, 0, At, B0); PG8_MMA(0, 1, At, B1); PG8_BAR; PG8_SCHED;
            PG8_LDA(At, 0, 1); PG8_STAGE(PG8_SB(0, 0), b2, voffB); PG8_STAGE(PG8_SB(0, 1), b2 + hstep, voffB); PG8_STAGE(PG8_SA(0, 0), a2, voffA);
            PG8_WAIT_V(8); PG8_WAIT_L(0); PG8_BAR; PG8_MMA(1, 0, At, B0); PG8_MMA(1, 1, At, B1); PG8_BAR; PG8_SCHED;
            PG8_LDB(B0, 1, 0); PG8_LDB(B1, 1, 1); PG8_SCHED; PG8_LDA(At, 1, 0); PG8_STAGE(PG8_SA(0, 1), a2 + hstep, voffA);
            PG8_WAIT_V(8); PG8_WAIT_L(0); PG8_BAR; PG8_MMA(0, 0, At, B0); PG8_MMA(0, 1, At, B1); PG8_BAR; PG8_SCHED;
            PG8_LDA(At, 1, 1); PG8_STAGE(PG8_SB(1, 0), b3, voffB); PG8_STAGE(PG8_SB(1, 1), b3 + hstep, voffB); PG8_STAGE(PG8_SA(1, 0), a3, voffA);
            PG8_WAIT_V(8); PG8_WAIT_L(0); PG8_BAR; PG8_MMA(1, 0, At, B0); PG8_MMA(1, 1, At, B1); PG8_BAR; PG8_SCHED;
            } else {
            PG8_LDB(B0, 0, 0); PG8_SCHED; PG8_LDA(At, 0, 0); PG8_STAGE(PG8_SA(1, 1), a1 + hstep, voffA);
            PG8_WAIT_L(8); PG8_BAR; PG8_WAIT_L(0); PG8_MMA(0, 0, At, B0); PG8_BAR; PG8_SCHED;
            PG8_LDB(B1, 0, 1); PG8_STAGE(PG8_SB(0, 0), b2, voffB);
            PG8_BAR; PG8_WAIT_L(0); PG8_MMA(0, 1, At, B1); PG8_BAR;
            PG8_LDA(At, 0, 1); PG8_STAGE(PG8_SA(0, 0), a2, voffA);
            PG8_BAR; PG8_WAIT_L(0); PG8_MMA(1, 0, At, B0); PG8_BAR; PG8_SCHED;
            PG8_STAGE(PG8_SB(0, 1), b2 + hstep, voffB);
            PG8_WAIT_V(6); PG8_BAR; PG8_MMA(1, 1, At, B1); PG8_BAR;
            PG8_LDB(B0, 1, 0); PG8_SCHED; PG8_LDA(At, 1, 0); PG8_STAGE(PG8_SA(0, 1), a2 + hstep, voffA);
            PG8_WAIT_L(8); PG8_BAR; PG8_WAIT_L(0); PG8_MMA(0, 0, At, B0); PG8_BAR; PG8_SCHED;
            PG8_LDB(B1, 1, 1); PG8_STAGE(PG8_SB(1, 0), b3, voffB);
            PG8_BAR; PG8_WAIT_L(0); PG8_MMA(0, 1, At, B1); PG8_BAR;
            PG8_LDA(At, 1, 1); PG8_STAGE(PG8_SA(1, 0), a3, voffA);
            PG8_BAR; PG8_WAIT_L(0); PG8_MMA(1, 0, At, B0); PG8_BAR; PG8_SCHED;
            PG8_STAGE(PG8_SB(1, 1), b3 + hstep, voffB);
            PG8_WAIT_V(6); PG8_BAR; PG8_MMA(1, 1, At, B1); PG8_BAR;
            }
        }
        if constexpr (ALIGN_EPI) { if (wr == 0) PG8_BAR; }
        if constexpr (!Epi::AFTER_DRAIN) { E(acc, cur, wr, wc, fr, fq); S.done(cur); }
        if (!has_next) break;
#pragma unroll
        for (int a = 0; a < 2; ++a)
#pragma unroll
            for (int b = 0; b < 2; ++b)
#pragma unroll
                for (int m = 0; m < 4; ++m)
#pragma unroll
                    for (int n = 0; n < 2; ++n) acc[a][b][m][n] = (f32x4){0.f, 0.f, 0.f, 0.f};
        cur = nxt; cA = nA; cB = nB; ++ui;
        if constexpr (ALIGN_EPI) { if (wr == 1) PG8_BAR; }
    }
    PG8_WAIT_V(0);
    if constexpr (!ALIGN_EPI) { if (wr == 0) PG8_BAR; }
    PG8_BAR;
    if constexpr (Epi::AFTER_DRAIN) { E.fused(acc, cur, wr, wc, fr, fq, lds, wid, lane); S.done(cur); }
#undef PG8_SA
#undef PG8_SB
#undef PG8_STAGE
#undef PG8_LDA
#undef PG8_LDB
#undef PG8_MMA
#undef PG8_WAIT_V
#undef PG8_WAIT_L
#undef PG8_BAR
#undef PG8_SCHED
}
}
namespace att {
typedef unsigned short bf16_t;
typedef short bf16x8 __attribute__((ext_vector_type(8)));
typedef short s16x4 __attribute__((ext_vector_type(4)));
typedef float f32x16 __attribute__((ext_vector_type(16)));
typedef unsigned u32x4 __attribute__((ext_vector_type(4)));
constexpr int NW = 8, QBLK = 32, KVBLK = 64, QB = NW * QBLK;
constexpr int SHM_V = KVBLK * 128 * 2, SHM_K = KVBLK * 256;
constexpr int LDS_BYTES = 2 * SHM_V + 2 * SHM_K + NW * 64 * 4;
constexpr float SCALE = 0.125f, THR = 8.f;
constexpr int QP = 512, KP = 512, VP = 512, OP = 1024;
#define KSWZ(row, colB) ((row) * 256 + ((colB) ^ (((row) & 7) << 4)))
#define SBAR() __builtin_amdgcn_sched_barrier(0)
__device__ __forceinline__ int v_st(int k, int c) { const int kk = (k & ~0xC) | ((k & 4) << 1) | ((k & 8) >> 1); return ((kk >> 3) * 4 + (c >> 5)) * 512 + ((kk & 7) * 32 + (c & 31)) * 2; }
__device__ __forceinline__ int v_rd_base(int lane) { return ((lane & 3) << 3) | (((lane >> 2) & 3) << 6) | (((lane >> 4) & 1) << 5) | (((lane >> 5) & 1) << 8); }
constexpr int v_rd_off(int d0, int ks, int half) { return d0 * 512 + ks * 4096 + half * 2048; }
__device__ __forceinline__ int crow(int r, int hi) { return (r & 3) + 8 * (r >> 2) + 4 * hi; }
__device__ __forceinline__ unsigned cvtpk(float lo, float hi) { unsigned r; asm volatile("v_cvt_pk_bf16_f32 %0, %1, %2" : "=v"(r) : "v"(lo), "v"(hi)); return r; }
__device__ __forceinline__ bf16x8 load8(const bf16_t* p) { return *reinterpret_cast<const bf16x8*>(p); }
__device__ __forceinline__ void mask_tile(f32x16& p0, f32x16& p1, int dq) {
    const float NEG = -__builtin_inff();
#pragma unroll
    for (int r = 0; r < 16; ++r) {
        const int c = (r & 3) + 8 * (r >> 2);
        if (dq - c < 0) p0[r] = NEG;
        if (dq - c - 32 < 0) p1[r] = NEG;
    }
}
__device__ __forceinline__ void partialSM(f32x16& p0, f32x16& p1, float& m_reg, float& mn, float& alpha) {
    float pmax = p0[0];
#pragma unroll
    for (int r = 1; r < 16; ++r) pmax = fmaxf(pmax, p0[r]);
#pragma unroll
    for (int r = 0; r < 16; ++r) pmax = fmaxf(pmax, p1[r]);
    { auto rr = __builtin_amdgcn_permlane32_swap(__float_as_uint(pmax), __float_as_uint(pmax), false, false);
      pmax = fmaxf(__uint_as_float(rr[0]), __uint_as_float(rr[1])); }
    constexpr float C2 = 1.4426950408889634f * SCALE;
    if (__builtin_expect(__all((pmax - m_reg) * SCALE <= THR), 1)) { mn = m_reg; alpha = 1.f; }
    else { mn = fmaxf(m_reg, pmax); alpha = __builtin_amdgcn_exp2f((m_reg - mn) * C2); m_reg = mn; }
    const float mnL = -mn * C2;
#pragma unroll
    for (int r = 0; r < 16; ++r) p0[r] = fmaf(p0[r], C2, mnL);
#pragma unroll
    for (int r = 0; r < 16; ++r) p1[r] = fmaf(p1[r], C2, mnL);
#pragma unroll
    for (int r = 0; r < 16; ++r) p0[r] = __builtin_amdgcn_exp2f(p0[r]);
}
__device__ __forceinline__ void finishSM(f32x16& p0, f32x16& p1, float alpha, float& l_reg, bf16x8& pa0, bf16x8& pa1, bf16x8& pa2, bf16x8& pa3) {
#pragma unroll
    for (int r = 0; r < 16; ++r) p1[r] = __builtin_amdgcn_exp2f(p1[r]);
    float ps = 0;
#pragma unroll
    for (int r = 0; r < 16; ++r) ps += p0[r];
#pragma unroll
    for (int r = 0; r < 16; ++r) ps += p1[r];
    { auto rr = __builtin_amdgcn_permlane32_swap(__float_as_uint(ps), __float_as_uint(ps), false, false);
      ps = __uint_as_float(rr[0]) + __uint_as_float(rr[1]); }
    l_reg = l_reg * alpha + ps;
#define PK4(P, B_, OUT) do { unsigned a0 = cvtpk(P[B_+0], P[B_+1]), a1 = cvtpk(P[B_+2], P[B_+3]);                          \
        unsigned b0 = cvtpk(P[B_+4], P[B_+5]), b1 = cvtpk(P[B_+6], P[B_+7]);                                             \
        auto r0 = __builtin_amdgcn_permlane32_swap(a0, b0, false, false); auto r1 = __builtin_amdgcn_permlane32_swap(a1, b1, false, false); \
        u32x4 w = {r0[0], r1[0], r0[1], r1[1]}; OUT = *reinterpret_cast<bf16x8*>(&w); } while (0)
    PK4(p0, 0, pa0); PK4(p0, 8, pa1); PK4(p1, 0, pa2); PK4(p1, 8, pa3);
#undef PK4
}
template <int KB>
__device__ __forceinline__ void qkt(f32x16& p0, f32x16& p1, const char* K_lds, int r32, int hi, const bf16x8* qr) {
    p0 = f32x16{}; p1 = f32x16{};
#pragma unroll
    for (int d0 = 0; d0 < 4; ++d0) { const char* a = K_lds + KB * SHM_K + KSWZ(r32, (d0 * 16 + hi * 8) * 2);
        bf16x8 b0 = *reinterpret_cast<const bf16x8*>(a);
        bf16x8 b1 = *reinterpret_cast<const bf16x8*>(a + 32 * 256);
        p0 = __builtin_amdgcn_mfma_f32_32x32x16_bf16(b0, qr[d0], p0, 0, 0, 0);
        p1 = __builtin_amdgcn_mfma_f32_32x32x16_bf16(b1, qr[d0], p1, 0, 0, 0); }
}
template <int VB>
__device__ __forceinline__ void pv_tile(f32x16* o, int vb0, bf16x8 pa0, bf16x8 pa1, bf16x8 pa2, bf16x8 pa3) {
#define TRRD(dst, off) asm volatile("ds_read_b64_tr_b16 %0, %1 offset:%2" : "=&v"(dst) : "v"(vb0), "i"(off) : "memory")
#define PV_D0(d0) do { s16x4 l0, l1, l2, l3, h0, h1, h2, h3; constexpr int b_ = VB * SHM_V + v_rd_off(d0, 0, 0); \
        TRRD(l0, b_); TRRD(h0, b_ + 2048); TRRD(l1, b_ + 4096); TRRD(h1, b_ + 6144); TRRD(l2, b_ + 8192); TRRD(h2, b_ + 10240); TRRD(l3, b_ + 12288); TRRD(h3, b_ + 14336); \
        asm volatile("s_waitcnt lgkmcnt(0)" ::: "memory"); SBAR();   \
        o[d0] = __builtin_amdgcn_mfma_f32_32x32x16_bf16(pa0, (bf16x8){l0[0], l0[1], l0[2], l0[3], h0[0], h0[1], h0[2], h0[3]}, o[d0], 0, 0, 0);   \
        o[d0] = __builtin_amdgcn_mfma_f32_32x32x16_bf16(pa1, (bf16x8){l1[0], l1[1], l1[2], l1[3], h1[0], h1[1], h1[2], h1[3]}, o[d0], 0, 0, 0);   \
        o[d0] = __builtin_amdgcn_mfma_f32_32x32x16_bf16(pa2, (bf16x8){l2[0], l2[1], l2[2], l2[3], h2[0], h2[1], h2[2], h2[3]}, o[d0], 0, 0, 0);   \
        o[d0] = __builtin_amdgcn_mfma_f32_32x32x16_bf16(pa3, (bf16x8){l3[0], l3[1], l3[2], l3[3], h3[0], h3[1], h3[2], h3[3]}, o[d0], 0, 0, 0); } while (0)
    PV_D0(0); PV_D0(1); PV_D0(2); PV_D0(3);
#undef PV_D0
#undef TRRD
}
struct BlockRef { const bf16_t* Q; const bf16_t* K; const bf16_t* V; bf16_t* O; int P0; };
struct Seam { bf16x8 qr[4]; bf16x8 st_v0, st_v1, st_k0; };
#define VMW() asm volatile("s_waitcnt vmcnt(0)" ::: "memory")
#define VMWN(n) asm volatile("s_waitcnt vmcnt(%0)" :: "i"(n) : "memory")
#define SLOAD_H(Kp, Vp, k0) do { S.st_v0 = load8((Vp) + (size_t)((k0) + sr) * VP + sc); S.st_v1 = load8((Vp) + (size_t)((k0) + 32 + sr) * VP + sc);  \
                                 S.st_k0 = load8((Kp) + (size_t)((k0) + kr) * KP + kc); } while (0)
#define SWRITE_HK(bf) do { *(bf16x8*)(K_lds + (bf) * SHM_K + kws) = S.st_k0; } while (0)
#define SWRITE_HV(bf) do { *(bf16x8*)(V_lds + (bf) * SHM_V + vst0) = S.st_v0; *(bf16x8*)(V_lds + (bf) * SHM_V + vst1) = S.st_v1; } while (0)
#define SWRITE_H(bf) do { SWRITE_HV(bf); SWRITE_HK(bf); } while (0)
__device__ __forceinline__ void attn_prime(const BlockRef& cur, char* lds, Seam& S) {
    int tid_l = threadIdx.x; asm volatile("" : "+v"(tid_l));
    const int tid = tid_l, wid = __builtin_amdgcn_readfirstlane(tid >> 6), lane = tid & 63, r32 = lane & 31, hi = lane >> 5;
    const int sr = tid >> 4, sc = (tid & 15) * 8, kr = tid >> 3, kc = (tid & 7) * 8, kws = KSWZ(kr, kc * 2); char* K_lds = lds + 2 * SHM_V;
#pragma unroll
    for (int d0 = 0; d0 < 4; ++d0) S.qr[d0] = load8(cur.Q + (size_t)(wid * QBLK + r32) * QP + d0 * 16 + hi * 8);
    SLOAD_H(cur.K, cur.V, 0); VMW(); SWRITE_HK(0);
    __syncthreads();
}
__device__ __forceinline__ void attn_block(const BlockRef& cur, const BlockRef& nxt, char* lds, Seam& S) {
    int tid_l = threadIdx.x; asm volatile("" : "+v"(tid_l));
    const int tid = tid_l, wid = __builtin_amdgcn_readfirstlane(tid >> 6), lane = tid & 63, r32 = lane & 31, hi = lane >> 5;
    const int NT = (cur.P0 + QB) / KVBLK;
    const int qlo = cur.P0 + wid * QBLK, qm = qlo + r32 - 4 * hi;
    char* V_lds = lds; char* K_lds = lds + 2 * SHM_V;
    float* ws = (float*)(lds + 2 * SHM_V + 2 * SHM_K) + wid * 64; float* li_l = ws, * al_l = ws + 32;
    float m_reg = -1e30f, l_reg = 0; f32x16 o[4] = {};
    const int sr = tid >> 4, sc = (tid & 15) * 8, vst0 = v_st(sr, sc), vst1 = v_st(32 + sr, sc);
    const int kr = tid >> 3, kc = (tid & 7) * 8, kws = KSWZ(kr, kc * 2);
    const int vb0 = (int)(uintptr_t)V_lds + v_rd_base(lane);
    const bf16_t* Kh = cur.K; const bf16_t* Vh = cur.V;
#define RESC(a) do { if (__any((a) < 1.f)) { if (hi == 0) al_l[r32] = (a); asm volatile("s_waitcnt lgkmcnt(0)" ::: "memory");              \
                     _Pragma("unroll") for (int d_ = 0; d_ < 4; ++d_) _Pragma("unroll") for (int r = 0; r < 16; ++r) o[d_][r] *= al_l[crow(r, hi)]; } } while (0)
#define KBASE(t) ((t) * KVBLK)
#define MASKT(P0_, P1_, t) do { const int kb_ = KBASE(t); if (kb_ + KVBLK - 1 > qlo) mask_tile(P0_, P1_, qm - kb_); } while (0)
    constexpr int NQL = 4;
#define SEAM_K0() do { VMWN(NQL); SWRITE_HK(0); SBAR(); } while (0)
    f32x16 pA0, pA1, pB0, pB1; float mnA, mnB, alA, alB; bf16x8 pa0, pa1, pa2, pa3;
    SWRITE_HV(0); SBAR();
    if (NT > 1) { SLOAD_H(Kh, Vh, KBASE(1)); }
    SBAR(); qkt<0>(pA0, pA1, K_lds, r32, hi, S.qr);
    MASKT(pA0, pA1, 0); partialSM(pA0, pA1, m_reg, mnA, alA);
    if (NT > 1) { VMW(); SWRITE_H(1); }
    __syncthreads();
#define HALF_STEP(PX0, PX1, mnX, alX, PY0, PY1, alY, t, KB, VB, SB) do {                                                      \
        SBAR(); qkt<KB>(PX0, PX1, K_lds, r32, hi, S.qr);                                                                      \
        finishSM(PY0, PY1, alY, l_reg, pa0, pa1, pa2, pa3); SBAR();                                                           \
        if ((t) + 1 < NT) { SLOAD_H(Kh, Vh, KBASE((t) + 1)); SBAR(); }                                                       \
        pv_tile<VB>(o, vb0, pa0, pa1, pa2, pa3); MASKT(PX0, PX1, (t)); partialSM(PX0, PX1, m_reg, mnX, alX);                  \
        __syncthreads();                                                                                                      \
        if ((t) + 1 < NT) { VMW(); SWRITE_H(SB); }                                                                            \
        RESC(alX); __syncthreads(); } while (0)
    for (int t = 1; t + 1 < NT; t += 2) {
        HALF_STEP(pB0, pB1, mnB, alB, pA0, pA1, alA, t, 1, 0, 0);
        HALF_STEP(pA0, pA1, mnA, alA, pB0, pB1, alB, t + 1, 0, 1, 1);
    }
    const bool even = (NT & 1) == 0;
    if (even) { SBAR(); qkt<1>(pB0, pB1, K_lds, r32, hi, S.qr); SBAR(); }
    SLOAD_H(nxt.K, nxt.V, 0); SBAR();
#pragma unroll
    for (int d0 = 0; d0 < 4; ++d0) S.qr[d0] = load8(nxt.Q + (size_t)(wid * QBLK + r32) * QP + d0 * 16 + hi * 8);
    SBAR();
    finishSM(pA0, pA1, alA, l_reg, pa0, pa1, pa2, pa3); SBAR();
    pv_tile<0>(o, vb0, pa0, pa1, pa2, pa3);
    if (even) { MASKT(pB0, pB1, NT - 1); partialSM(pB0, pB1, m_reg, mnB, alB); __syncthreads(); RESC(alB);
        finishSM(pB0, pB1, alB, l_reg, pa0, pa1, pa2, pa3); SBAR(); pv_tile<1>(o, vb0, pa0, pa1, pa2, pa3); }
    SBAR(); SEAM_K0();
    if (hi == 0) li_l[r32] = l_reg; asm volatile("s_waitcnt lgkmcnt(0)" ::: "memory");
    float rli[16];
#pragma unroll
    for (int r = 0; r < 16; ++r) rli[r] = __builtin_amdgcn_rcpf(li_l[crow(r, hi)]);
    bf16_t* Ow = cur.O + (size_t)(wid * QBLK) * OP;
#pragma unroll
    for (int r = 0; r < 16; ++r) { const int orow = crow(r, hi);
#pragma unroll
        for (int d0 = 0; d0 < 4; ++d0) { const float v = o[d0][r] * rli[r];
            const float vn = __shfl_xor(v, 1);
            if ((r32 & 1) == 0) *(unsigned*)(Ow + (size_t)orow * OP + d0 * 32 + r32) = cvtpk(v, vn); } }
    __syncthreads();
#undef RESC
#undef KBASE
#undef MASKT
#undef SEAM_K0
#undef HALF_STEP
}
#undef VMW
#undef VMWN
#undef SLOAD_H
#undef SWRITE_HK
#undef SWRITE_HV
#undef SWRITE_H
#undef KSWZ
#undef SBAR
}
#define GAS __attribute__((address_space(1)))
#define LAS __attribute__((address_space(3)))
typedef unsigned short bf16;
typedef unsigned v4u __attribute__((ext_vector_type(4)));
typedef float f32x4 __attribute__((ext_vector_type(4)));
typedef short bf16x8 __attribute__((ext_vector_type(8)));
typedef GAS unsigned gu32;
typedef GAS unsigned long long gu64;
#define RLX_AGENT __ATOMIC_RELAXED, __HIP_MEMORY_SCOPE_AGENT
#define LDS_WAIT() asm volatile("s_waitcnt lgkmcnt(0)" ::: "memory")
#define VM_WAIT() asm volatile("s_waitcnt vmcnt(0)" ::: "memory")
__device__ __forceinline__ unsigned long long rt() { return __builtin_amdgcn_s_memrealtime(); }
__device__ __forceinline__ unsigned f2bf(float f) { unsigned u = __builtin_bit_cast(unsigned, f); return (u + 0x7fffu + ((u >> 16) & 1u)) >> 16; }
__device__ __forceinline__ unsigned pk2(float lo, float hi) { return f2bf(lo) | (f2bf(hi) << 16); }

#define XB_TMO      128
#define XB_XCNT(j)  (256  + 64 * (j))
#define XB_XSUB(j)  (1280 + 64 * (j))
#define XB_XGEN(j)  (2304 + 64 * (j))
#define XB_TOP      3328
#define XB_TOPGEN   3392
#define XCD_BAR_WORDS 3456
#define XB_SPIN_CAP (1u << 18)

__device__ __forceinline__ unsigned xb_ld(unsigned* p)              { return __hip_atomic_load(p, __ATOMIC_RELAXED, __HIP_MEMORY_SCOPE_AGENT); }
__device__ __forceinline__ unsigned xb_add(unsigned* p, unsigned v) { return __hip_atomic_fetch_add(p, v, __ATOMIC_RELAXED, __HIP_MEMORY_SCOPE_AGENT); }
__device__ __forceinline__ unsigned xb_xcc_id() { return (unsigned)__builtin_amdgcn_s_getreg((3 << 11) | 20) & 0xFu; }
#define XB_SPIN(cond, bar) do { unsigned _sp = 0; while (cond) { __builtin_amdgcn_s_sleep(1); \
    if ((++_sp & 255u) == 0u) { if (xb_ld(&(bar)[XB_TMO])) break; if (_sp > XB_SPIN_CAP) { atomicAdd(&(bar)[XB_TMO], 1u); break; } } } } while (0)

struct XcdBarrier {
    unsigned* bar; unsigned x;
    volatile LAS unsigned* st;
};

__device__ __forceinline__ XcdBarrier xcd_barrier_post(unsigned* bar, volatile LAS unsigned* st) {
    XcdBarrier b; b.bar = bar; b.x = xb_xcc_id(); b.st = st;
    if (threadIdx.x == 0) (void)xb_add(&bar[XB_XCNT(b.x)], 1u);
    return b;
}
__device__ __forceinline__ void xcd_barrier_complete(unsigned* bar, unsigned x, unsigned& nloc, unsigned& nx) {
    const unsigned G = gridDim.x * gridDim.y * gridDim.z;
    unsigned sum, cnt, mine, sp = 0u;
    for (;;) {
        sum = 0u; cnt = 0u; mine = 0u;
#pragma unroll
        for (unsigned j = 0; j < 16; ++j) { const unsigned c = xb_ld(&bar[XB_XCNT(j)]); sum += c; cnt += (c > 0u) ? 1u : 0u; mine = (j == x) ? c : mine; }
        if (sum == G) break;
        __builtin_amdgcn_s_sleep(1);
        if ((++sp & 255u) == 0u) { if (xb_ld(&bar[XB_TMO])) break; if (sp > XB_SPIN_CAP) { atomicAdd(&bar[XB_TMO], 1u); break; } }
    }
    nloc = mine > 0u ? mine : 1u; nx = cnt > 0u ? cnt : 1u;
}

__device__ __forceinline__ void xcd_barrier(const XcdBarrier& b) {
    asm volatile("s_waitcnt vmcnt(0)" ::: "memory");
    __syncthreads();
    if (threadIdx.x == 0) {
        unsigned* bar = b.bar;
        __builtin_amdgcn_s_waitcnt(0);
        unsigned nloc = b.st[0], nx = b.st[1];
        if (nloc == 0u) { xcd_barrier_complete(bar, b.x, nloc, nx); b.st[0] = nloc; b.st[1] = nx; }
        const unsigned old = xb_add(&bar[XB_XSUB(b.x)], 1u);
        const unsigned gen = old / nloc;
        if (old + 1u == (gen + 1u) * nloc) {
            __builtin_amdgcn_fence(__ATOMIC_RELEASE, "agent");
            asm volatile("s_waitcnt vmcnt(0)" ::: "memory");
            const unsigned og = xb_add(&bar[XB_TOP], 1u);
            const unsigned tg = og / nx;
            if (og + 1u == (tg + 1u) * nx) xb_add(&bar[XB_TOPGEN], 1u);
            else XB_SPIN(xb_ld(&bar[XB_TOPGEN]) == tg, bar);
            __builtin_amdgcn_fence(__ATOMIC_ACQUIRE, "agent");
            xb_add(&bar[XB_XGEN(b.x)], 1u);
            asm volatile("s_waitcnt vmcnt(0)" ::: "memory");
        } else {
            XB_SPIN(xb_ld(&bar[XB_XGEN(b.x)]) == gen, bar);
            __builtin_amdgcn_fence(__ATOMIC_ACQUIRE, "agent");
            asm volatile("s_waitcnt vmcnt(0)" ::: "memory");
        }
    }
    __syncthreads();
}
constexpr int NWAVES = 8;
constexpr int DM = 1024, MP = pg8::MP, MS = pg8::MS, MT = pg8::MT, SEQ = 8192, NIN = 3072, DFF = 2816, NUP = 2 * DFF;
constexpr int DEC_B = 128, DEC_T = 4, N_PAGES = 16, PAGE = 128, N_ITEMS = 17;
constexpr size_t MiB = 1u << 20;
constexpr size_t WS_CTL = 0, CTL_ZERO_BYTES = 1 * MiB;
constexpr size_t WS_TAB = 1 * MiB;
constexpr size_t TAB_COSD = WS_TAB, TAB_SIND = TAB_COSD + 262144, TAB_COSR = TAB_SIND + 262144, TAB_SINR = TAB_COSR + 1048576;
constexpr size_t WS_WIN = 4 * MiB, WS_WOUT = 10 * MiB, WS_WUP = 12 * MiB, WS_WDN = 23 * MiB;
constexpr size_t WS_XN = 32 * MiB;
constexpr size_t WS_DQ = 66 * MiB, WS_DK = 83 * MiB, WS_DV = 100 * MiB, WS_RV = 117 * MiB, WS_RG = 134 * MiB;
constexpr size_t WS_RQ = 151 * MiB, WS_RK = 160 * MiB;
constexpr size_t WS_OA = 169 * MiB;
constexpr size_t WS_CAT = 202 * MiB;
constexpr size_t WS_DECO = 236 * MiB;
constexpr size_t WS_DECML = 271 * MiB;
constexpr size_t WS_KV = 272 * MiB;
constexpr size_t WS_ST = 288 * MiB;
constexpr size_t WS_X1 = 296 * MiB;
constexpr size_t WS_X1B = 362 * MiB;
constexpr size_t WS_SSQ = 395 * MiB;
constexpr size_t WS_H = 398 * MiB;
constexpr size_t WS_END = 489 * MiB;
constexpr int CW_TMO = 0, CW_CODE = 1, CW_BAR = 4096;
constexpr int RING_OFF = 0, RING_BYTES = 131072;
constexpr int LDSCTL_OFF = RING_BYTES, MISC_OFF = LDSCTL_OFF + 320;
constexpr int LDS_BYTES = 147456;
static_assert(att::LDS_BYTES <= RING_BYTES && pg8::STAGE_BYTES <= RING_BYTES, "LDS map");

__constant__ double INV_D[8] = {1, 0.19392274474868576, 0.037606030930863933, 0.0072926647372171093, 0.001414213562373095, 0.0002742481756762073, 5.3182958969449883e-05, 1.031338537721246e-05};
__constant__ double INV_R[32] = {1, 0.74989420933245587, 0.56234132519034907, 0.42169650342858223, 0.31622776601683794, 0.23713737056616552, 0.17782794100389229, 0.1333521432163324, 0.10000000000000001, 0.074989420933245579, 0.056234132519034911, 0.042169650342858224, 0.031622776601683791, 0.023713737056616554, 0.017782794100389229, 0.013335214321633241, 0.01, 0.0074989420933245579, 0.005623413251903491, 0.0042169650342858229, 0.0031622776601683794, 0.0023713737056616554, 0.0017782794100389228, 0.0013335214321633241, 0.001, 0.00074989420933245586, 0.0005623413251903491, 0.00042169650342858224, 0.00031622776601683794, 0.00023713737056616554, 0.00017782794100389227, 0.0001333521432163324};
__device__ __forceinline__ float log2_gamma(int h) { return h == 0 ? -0.045803689613124789f : h == 1 ? -0.022720076500083529f : h == 2 ? -0.011315313227834146f : -0.0056465631411420627f; }

struct Frame {
    LAS unsigned char* lds;
    volatile LAS unsigned* MISC;
    gu32* ctl;
    int tid, lane, wave, vcu, G;
};
__device__ __forceinline__ float wave_sum(float v) {
#pragma unroll
    for (int o = 1; o < 64; o <<= 1) v += __shfl_xor(v, o);
    return v;
}
__device__ __forceinline__ float bf2f(bf16 b) { return __uint_as_float((unsigned)b << 16); }
__device__ __forceinline__ float bflo(unsigned w) { return __uint_as_float(w << 16); }
__device__ __forceinline__ float bfhi(unsigned w) { return __uint_as_float(w & 0xffff0000u); }

__device__ __forceinline__ int perm_in(int n) {
    if (n < 1024) { const int d = n & 63; if (d < 16) { const int i = d & 7, half = d >> 3; return (n & ~63) + ((i >> 2) << 3) + (half << 2) + (i & 3); } return n; }
    if (n >= 1536 && n < 2048) { const int d = n & 63, i = d & 31, half = d >> 5; return (n & ~63) + ((i >> 2) << 3) + (half << 2) + (i & 3); }
    return n;
}
__device__ __forceinline__ int perm_up(int n) { const int part = n >= DFF ? 1 : 0, f = part ? n - DFF : n; return ((f >> 2) << 3) + (part << 2) + (f & 3); }
template <int PERM>
__device__ __forceinline__ void p0_transpose_item(const float* W, int K, int N, bf16* WT, const float* gain, LAS float* scr, int item, int lane) {
    const int nblk = N / 32, kb = item / nblk, nb = item % nblk, k0 = 64 * kb, n0 = 32 * nb;
#pragma unroll 8
    for (int i = 0; i < 32; ++i) { const int kk = 2 * i + (lane >> 5); float w = W[(size_t)(k0 + kk) * N + n0 + (lane & 31)]; if (gain) w *= gain[k0 + kk]; scr[kk * 33 + (lane & 31)] = w; }
    LDS_WAIT(); asm volatile("" ::: "memory");
    const int c = lane & 7;
#pragma unroll
    for (int j = 0; j < 4; ++j) { const int n = (lane >> 3) + 8 * j; const LAS float* s = scr + (8 * c) * 33 + n;
        v4u o; o.x = pk2(s[0 * 33], s[1 * 33]); o.y = pk2(s[2 * 33], s[3 * 33]); o.z = pk2(s[4 * 33], s[5 * 33]); o.w = pk2(s[6 * 33], s[7 * 33]);
        const int nl = n0 + n, np = PERM == 1 ? perm_in(nl) : PERM == 2 ? perm_up(nl) : nl;
        *(GAS v4u*)(WT + (size_t)np * K + k0 + 8 * c) = o; }
    LDS_WAIT(); asm volatile("" ::: "memory");
}
__device__ __forceinline__ void rms_row_to_bf16(int lane, const float* xrow, const float* g, bf16* orow) {
    const GAS f32x4* xr = (const GAS f32x4*)xrow + lane; const GAS f32x4* gr = (const GAS f32x4*)g + lane;
    f32x4 v[4]; float s = 0.f;
#pragma unroll
    for (int j = 0; j < 4; ++j) { v[j] = xr[64 * j]; s += (v[j].x * v[j].x + v[j].y * v[j].y) + (v[j].z * v[j].z + v[j].w * v[j].w); }
    const float r = 1.f / sqrtf(wave_sum(s) * (1.f / DM) + 1e-6f);
    GAS unsigned long long* o8 = (GAS unsigned long long*)orow + lane;
#pragma unroll
    for (int j = 0; j < 4; ++j) { const f32x4 gg = gr[64 * j]; o8[64 * j] = (unsigned long long)pk2(v[j].x * r * gg.x, v[j].y * r * gg.y) | ((unsigned long long)pk2(v[j].z * r * gg.z, v[j].w * r * gg.w) << 32); }
}
__device__ __forceinline__ void sincos_d(double x, float& s, float& c) {
    const double k = __builtin_rint(x * 0.63661977236758134308);
    double r = __builtin_fma(-k, 1.57079632679489655800e+00, x); r = __builtin_fma(-k, 6.12323399573676603587e-17, r);
    const double r2 = r * r;
    const double sp = r * (1.0 + r2 * (-1.0 / 6 + r2 * (1.0 / 120 + r2 * (-1.0 / 5040 + r2 * (1.0 / 362880 + r2 * (-1.0 / 39916800 + r2 * (1.0 / 6227020800.0)))))));
    const double cp = 1.0 + r2 * (-0.5 + r2 * (1.0 / 24 + r2 * (-1.0 / 720 + r2 * (1.0 / 40320 + r2 * (-1.0 / 3628800 + r2 * (1.0 / 479001600.0 + r2 * (-1.0 / 87178291200.0)))))));
    const int q = ((int)k) & 3;
    const double ss = (q == 0) ? sp : (q == 1) ? cp : (q == 2) ? -sp : -cp;
    const double cc = (q == 0) ? cp : (q == 1) ? -sp : (q == 2) ? -cp : sp;
    s = (float)ss; c = (float)cc;
}

typedef float f32x4m __attribute__((ext_vector_type(4)));
__device__ __forceinline__ bf16x8 lfrag(const LAS unsigned char* base, int row, int ldb, int kbyte) { return *(const LAS bf16x8*)(base + row * ldb + kbyte); }
#define MFMA16(a, b, c) __builtin_amdgcn_mfma_f32_16x16x32_bf16((a), (b), (c), 0, 0, 0)

constexpr int LDT = 136 * 2;
constexpr int LDH = 72 * 2;
__device__ __forceinline__ void ret_kv_unit(Frame& F, int bh, int c, const bf16* RK, const bf16* RV, float* KV) {
    LAS unsigned char* VT = F.lds;
    LAS unsigned char* KT = F.lds + 128 * LDT;
    const int b = bh >> 2, h = bh & 3; const size_t R0 = (size_t)b * SEQ + (size_t)c * 128;
    const float lg = log2_gamma(h);
    for (int idx = F.tid; idx < 2048; idx += 512) { const int j = idx & 127, ec = idx >> 7;
        const v4u w = *(const GAS v4u*)(RV + (R0 + j) * 512 + h * 128 + ec * 8);
        const unsigned ww[4] = {w.x, w.y, w.z, w.w};
#pragma unroll
        for (int q = 0; q < 4; ++q) { *(LAS bf16*)(VT + (ec * 8 + 2 * q) * LDT + j * 2) = (bf16)(ww[q] & 0xffffu); *(LAS bf16*)(VT + (ec * 8 + 2 * q + 1) * LDT + j * 2) = (bf16)(ww[q] >> 16); } }
    for (int idx = F.tid; idx < 1024; idx += 512) { const int j = idx & 127, dc = idx >> 7;
        const v4u w = *(const GAS v4u*)(RK + (R0 + j) * 256 + h * 64 + dc * 8);
        const float dec = __builtin_amdgcn_exp2f(lg * (float)(127 - j));
        const unsigned ww[4] = {w.x, w.y, w.z, w.w};
#pragma unroll
        for (int q = 0; q < 4; ++q) { *(LAS bf16*)(KT + (dc * 8 + 2 * q) * LDT + j * 2) = (bf16)f2bf(bflo(ww[q]) * dec); *(LAS bf16*)(KT + (dc * 8 + 2 * q + 1) * LDT + j * 2) = (bf16)f2bf(bfhi(ww[q]) * dec); } }
    LDS_WAIT(); __syncthreads();
    const int fr = F.lane & 15, fq = F.lane >> 4, w = F.wave;
    f32x4m acc[4];
#pragma unroll
    for (int nj = 0; nj < 4; ++nj) acc[nj] = (f32x4m){0.f, 0.f, 0.f, 0.f};
#pragma unroll
    for (int ks = 0; ks < 4; ++ks) { const bf16x8 a = lfrag(VT, 16 * w + fr, LDT, (32 * ks + 8 * fq) * 2);
#pragma unroll
        for (int nj = 0; nj < 4; ++nj) acc[nj] = MFMA16(a, lfrag(KT, 16 * nj + fr, LDT, (32 * ks + 8 * fq) * 2), acc[nj]); }
    float* dst = KV + ((size_t)bh * 64 + c) * 8192;
#pragma unroll
    for (int nj = 0; nj < 4; ++nj)
#pragma unroll
        for (int r = 0; r < 4; ++r) dst[(16 * w + 4 * fq + r) * 64 + 16 * nj + fr] = acc[nj][r];
    __syncthreads();
}
__device__ __forceinline__ void ret_out_unit(Frame& F, int bh, int c, const bf16* RQ, const bf16* RK, const bf16* RV, const bf16* RGs, const bf16* ST, bf16* CAT) {
    LAS unsigned char* Qs = F.lds;
    LAS unsigned char* Ks = Qs + 128 * LDH;
    LAS unsigned char* VT = Ks + 128 * LDH;
    LAS unsigned char* STs = VT + 128 * LDT;
    LAS unsigned char* Ps = STs + 128 * LDH;
    LAS float* OS = (LAS float*)F.lds;
    static_assert(128 * LDH * 3 + 128 * LDT * 2 <= RING_BYTES && 128 * 132 * 4 <= 128 * LDH * 2 + 128 * LDT, "retention LDS map");
    const int b = bh >> 2, h = bh & 3; const size_t R0 = (size_t)b * SEQ + (size_t)c * 128;
    const float lg = log2_gamma(h);
    for (int idx = F.tid; idx < 1024; idx += 512) { const int i = idx >> 3, ch = idx & 7;
        const v4u q = *(const GAS v4u*)(RQ + (R0 + i) * 256 + h * 64 + ch * 8);
        *(LAS v4u*)(Qs + i * LDH + ch * 16) = q;
        *(LAS v4u*)(Ks + i * LDH + ch * 16) = *(const GAS v4u*)(RK + (R0 + i) * 256 + h * 64 + ch * 8);
        *(LAS v4u*)(STs + i * LDH + ch * 16) = *(const GAS v4u*)(ST + ((size_t)bh * 64 + c) * 8192 + i * 64 + ch * 8); }
    for (int idx = F.tid; idx < 2048; idx += 512) { const int j = idx & 127, ec = idx >> 7;
        const v4u w = *(const GAS v4u*)(RV + (R0 + j) * 512 + h * 128 + ec * 8);
        const unsigned ww[4] = {w.x, w.y, w.z, w.w};
#pragma unroll
        for (int q = 0; q < 4; ++q) { *(LAS bf16*)(VT + (ec * 8 + 2 * q) * LDT + j * 2) = (bf16)(ww[q] & 0xffffu); *(LAS bf16*)(VT + (ec * 8 + 2 * q + 1) * LDT + j * 2) = (bf16)(ww[q] >> 16); } }
    LDS_WAIT(); __syncthreads();
    const int fr = F.lane & 15, fq = F.lane >> 4, w = F.wave;
    const int njmax = w | 1;
#pragma unroll
    for (int nj = 0; nj < 8; ++nj) if (nj <= njmax) {
        f32x4m s = (f32x4m){0.f, 0.f, 0.f, 0.f};
#pragma unroll
        for (int ks = 0; ks < 2; ++ks) s = MFMA16(lfrag(Qs, 16 * w + fr, LDH, (32 * ks + 8 * fq) * 2), lfrag(Ks, 16 * nj + fr, LDH, (32 * ks + 8 * fq) * 2), s);
#pragma unroll
        for (int r = 0; r < 4; ++r) { const int i = 16 * w + 4 * fq + r, j = 16 * nj + fr;
            const float p = (j <= i) ? s[r] * __builtin_amdgcn_exp2f(lg * (float)(i - j)) : 0.f;
            *(LAS bf16*)(Ps + i * LDT + j * 2) = (bf16)f2bf(p); }
    }
    LDS_WAIT(); asm volatile("" ::: "memory");
    f32x4m acc[8];
#pragma unroll
    for (int nj = 0; nj < 8; ++nj) acc[nj] = (f32x4m){0.f, 0.f, 0.f, 0.f};
    const int ksmax = w >> 1;
#pragma unroll
    for (int ks = 0; ks < 4; ++ks) if (ks <= ksmax) { const bf16x8 a = lfrag(Ps, 16 * w + fr, LDT, (32 * ks + 8 * fq) * 2);
#pragma unroll
        for (int nj = 0; nj < 8; ++nj) acc[nj] = MFMA16(a, lfrag(VT, 16 * nj + fr, LDT, (32 * ks + 8 * fq) * 2), acc[nj]); }
    const float qdec = __builtin_amdgcn_exp2f(lg * (float)(16 * w + fr + 1));
#pragma unroll
    for (int ks = 0; ks < 2; ++ks) { const v4u qq = *(const LAS v4u*)(Qs + (16 * w + fr) * LDH + (32 * ks + 8 * fq) * 2);
        v4u q2; q2.x = pk2(bflo(qq.x) * qdec, bfhi(qq.x) * qdec); q2.y = pk2(bflo(qq.y) * qdec, bfhi(qq.y) * qdec); q2.z = pk2(bflo(qq.z) * qdec, bfhi(qq.z) * qdec); q2.w = pk2(bflo(qq.w) * qdec, bfhi(qq.w) * qdec);
        const bf16x8 a = __builtin_bit_cast(bf16x8, q2);
#pragma unroll
        for (int nj = 0; nj < 8; ++nj) acc[nj] = MFMA16(a, lfrag(STs, 16 * nj + fr, LDH, (32 * ks + 8 * fq) * 2), acc[nj]); }
    float rinv[4];
#pragma unroll
    for (int r = 0; r < 4; ++r) { float ss = 0.f;
#pragma unroll
        for (int nj = 0; nj < 8; ++nj) ss += acc[nj][r] * acc[nj][r];
        ss += __shfl_xor(ss, 1); ss += __shfl_xor(ss, 2); ss += __shfl_xor(ss, 4); ss += __shfl_xor(ss, 8);
        rinv[r] = 1.f / sqrtf(ss * (1.f / 128.f) + 1e-6f); }
    __syncthreads();
#pragma unroll
    for (int nj = 0; nj < 8; ++nj)
#pragma unroll
        for (int r = 0; r < 4; ++r) OS[(16 * w + 4 * fq + r) * 132 + 16 * nj + fr] = acc[nj][r] * rinv[r];
    LDS_WAIT(); __syncthreads();
    for (int idx = F.tid; idx < 2048; idx += 512) { const int i = idx >> 4, ec = idx & 15;
        const v4u g = *(const GAS v4u*)(RGs + (R0 + i) * 512 + h * 128 + ec * 8);
        const LAS float* os = OS + i * 132 + ec * 8;
        v4u o; o.x = pk2(os[0] * bflo(g.x), os[1] * bfhi(g.x)); o.y = pk2(os[2] * bflo(g.y), os[3] * bfhi(g.y)); o.z = pk2(os[4] * bflo(g.z), os[5] * bfhi(g.z)); o.w = pk2(os[6] * bflo(g.w), os[7] * bfhi(g.w));
        *(GAS v4u*)(CAT + (R0 + i) * 1024 + 512 + h * 128 + ec * 8) = o; }
    LDS_WAIT(); __syncthreads();
}

__device__ __forceinline__ float row16_sum(float v) {
    v += __int_as_float(__builtin_amdgcn_update_dpp(0, __float_as_int(v), 0x128, 0xf, 0xf, false));
    v += __int_as_float(__builtin_amdgcn_update_dpp(0, __float_as_int(v), 0x124, 0xf, 0xf, false));
    v += __int_as_float(__builtin_amdgcn_update_dpp(0, __float_as_int(v), 0x122, 0xf, 0xf, false));
    v += __int_as_float(__builtin_amdgcn_update_dpp(0, __float_as_int(v), 0x121, 0xf, 0xf, false));
    return v;
}
__device__ __forceinline__ f32x4 ntld4(const float* p) { return __builtin_nontemporal_load((const f32x4*)p); }
__device__ __forceinline__ void decode_item(const float* __restrict__ Kb, const float* __restrict__ Vb, int ntok, bool newtok, const bf16* qrows, LAS float* scr, float* po, float* pml, int lane) {
    const int hml = lane >> 4, c = lane & 15, row = lane >> 1, half = lane & 1, hl = lane >> 5;
    constexpr float QS = 0.125f * 1.4426950408889634f;
    f32x4 qv[2][4];
#pragma unroll
    for (int v = 0; v < 2; ++v)
#pragma unroll
        for (int tq = 0; tq < 4; ++tq) { const unsigned long long w = *(const GAS unsigned long long*)(qrows + tq * 512 + (4 * v + hml) * 64 + 4 * c);
            qv[v][tq] = (f32x4){bflo((unsigned)w) * QS, bfhi((unsigned)w) * QS, bflo((unsigned)(w >> 32)) * QS, bfhi((unsigned)(w >> 32)) * QS}; }
    f32x4 o[2][4][2];
#pragma unroll
    for (int v = 0; v < 2; ++v)
#pragma unroll
        for (int tq = 0; tq < 4; ++tq) { o[v][tq][0] = (f32x4){0.f, 0.f, 0.f, 0.f}; o[v][tq][1] = (f32x4){0.f, 0.f, 0.f, 0.f}; }
    float m_run = -1e30f, l_run = 0.f;
    const float NEG = -__builtin_inff();
    for (int t0 = 0; t0 < ntok; t0 += 16) {
#pragma unroll 1
        for (int tt = 0; tt < 16; tt += 4) {
            f32x4 kk[4][2];
#pragma unroll
            for (int i = 0; i < 4; ++i)
#pragma unroll
                for (int v = 0; v < 2; ++v) { const int t = t0 + tt + i; kk[i][v] = (t < ntok) ? ntld4(Kb + (size_t)t * 512 + v * 256 + lane * 4) : (f32x4){0.f, 0.f, 0.f, 0.f}; }
#pragma unroll
            for (int i = 0; i < 4; ++i)
#pragma unroll
                for (int v = 0; v < 2; ++v) { const int t = t0 + tt + i; float s[4];
#pragma unroll
                    for (int tq = 0; tq < 4; ++tq) { const f32x4 p = qv[v][tq] * kk[i][v]; s[tq] = row16_sum((p[0] + p[1]) + (p[2] + p[3])); }
                    float sv = (c == 0) ? s[0] : (c == 1) ? s[1] : (c == 2) ? s[2] : s[3];
                    if (t >= ntok || (newtok && t > c)) sv = NEG;
                    if (c < 4) scr[(tt + i) * 32 + (4 * v + hml) * 4 + c] = sv; }
        }
        asm volatile("s_waitcnt lgkmcnt(0)" ::: "memory");
        { float sv[8]; float bm = NEG;
#pragma unroll
            for (int i = 0; i < 8; ++i) { sv[i] = scr[(half * 8 + i) * 32 + row]; bm = fmaxf(bm, sv[i]); }
            bm = fmaxf(bm, __shfl_xor(bm, 1));
            const float mn = fmaxf(m_run, bm), alpha = __builtin_amdgcn_exp2f(m_run - mn); float ps = 0.f;
#pragma unroll
            for (int i = 0; i < 8; ++i) { const float p = __builtin_amdgcn_exp2f(sv[i] - mn); ps += p; scr[(half * 8 + i) * 32 + row] = p; }
            ps += __shfl_xor(ps, 1);
            l_run = l_run * alpha + ps; m_run = mn;
            if (half == 0) scr[512 + row] = alpha; }
        asm volatile("s_waitcnt lgkmcnt(0)" ::: "memory");
#pragma unroll
        for (int v = 0; v < 2; ++v) { const int h = 2 * v + hl; const f32x4 a0 = *(const LAS f32x4*)(scr + 512 + (h * 2 + 0) * 4), a1 = *(const LAS f32x4*)(scr + 512 + (h * 2 + 1) * 4);
#pragma unroll
            for (int tq = 0; tq < 4; ++tq) { o[v][tq][0] = o[v][tq][0] * a0[tq]; o[v][tq][1] = o[v][tq][1] * a1[tq]; } }
#pragma unroll 1
        for (int tt = 0; tt < 16; tt += 4) {
            f32x4 vv[4][2];
#pragma unroll
            for (int i = 0; i < 4; ++i)
#pragma unroll
                for (int v = 0; v < 2; ++v) { const int t = t0 + tt + i; vv[i][v] = (t < ntok) ? ntld4(Vb + (size_t)t * 512 + v * 256 + lane * 4) : (f32x4){0.f, 0.f, 0.f, 0.f}; }
#pragma unroll
            for (int i = 0; i < 4; ++i)
#pragma unroll
                for (int v = 0; v < 2; ++v) { const int h = 2 * v + hl;
                    const f32x4 p0 = *(const LAS f32x4*)(scr + (tt + i) * 32 + (h * 2 + 0) * 4), p1 = *(const LAS f32x4*)(scr + (tt + i) * 32 + (h * 2 + 1) * 4);
#pragma unroll
                    for (int tq = 0; tq < 4; ++tq) { o[v][tq][0] += vv[i][v] * p0[tq]; o[v][tq][1] += vv[i][v] * p1[tq]; } }
        }
        asm volatile("s_waitcnt lgkmcnt(0)" ::: "memory");
    }
    if (half == 0) { pml[row * 2] = m_run; pml[row * 2 + 1] = l_run; }
#pragma unroll
    for (int v = 0; v < 2; ++v)
#pragma unroll
        for (int tq = 0; tq < 4; ++tq)
#pragma unroll
            for (int m = 0; m < 2; ++m) *(f32x4*)(po + (((2 * v + hl) * 2 + m) * 4 + tq) * 128 + 4 * (lane & 31)) = o[v][tq][m];
}

__device__ __forceinline__ void sample_ret_item(int db, int h, int lane, const bf16* RQ, const bf16* RK, const bf16* RV, const bf16* RGs, const float* state, float* sout, bf16* CAT) {
    typedef float f32x2 __attribute__((ext_vector_type(2)));
    const int rowb = MP + db * 4; const float lg = log2_gamma(h);
    float qd[4], kd[4]; f32x2 vv[4];
#pragma unroll
    for (int i = 0; i < 4; ++i) { qd[i] = bf2f(RQ[(size_t)(rowb + i) * 256 + h * 64 + lane]); kd[i] = bf2f(RK[(size_t)(rowb + i) * 256 + h * 64 + lane]);
        const unsigned w = *(const GAS unsigned*)(RV + (size_t)(rowb + i) * 512 + h * 128 + 2 * lane); vv[i] = (f32x2){bflo(w), bfhi(w)}; }
    float gp[5];
#pragma unroll
    for (int n = 0; n < 5; ++n) gp[n] = __builtin_amdgcn_exp2f(lg * (float)n);
    f32x2 outv[4];
#pragma unroll
    for (int i = 0; i < 4; ++i) { outv[i] = (f32x2){0.f, 0.f};
#pragma unroll
        for (int j = 0; j <= i; ++j) { const float qk = wave_sum(qd[i] * kd[j]) * gp[i - j]; outv[i] += vv[j] * qk; } }
    const float* S = state + ((size_t)(db * 4 + h) * 64) * 128; float* SO = sout + ((size_t)(db * 4 + h) * 64) * 128;
    f32x2 cr[4] = {(f32x2){0.f, 0.f}, (f32x2){0.f, 0.f}, (f32x2){0.f, 0.f}, (f32x2){0.f, 0.f}};
#pragma unroll 4
    for (int d = 0; d < 64; ++d) {
        const f32x2 s = *(const f32x2*)(S + d * 128 + 2 * lane);
        f32x2 ns = s * gp[4];
#pragma unroll
        for (int i = 0; i < 4; ++i) { const float qs = __int_as_float(__builtin_amdgcn_readlane(__float_as_int(qd[i]), d)); cr[i] += s * qs;
            const float ks = __int_as_float(__builtin_amdgcn_readlane(__float_as_int(kd[i]), d)) * gp[3 - i]; ns += vv[i] * ks; }
        *(f32x2*)(SO + d * 128 + 2 * lane) = ns;
    }
#pragma unroll
    for (int i = 0; i < 4; ++i) { const f32x2 ov = outv[i] + cr[i] * gp[i + 1];
        const float ss = wave_sum(ov.x * ov.x + ov.y * ov.y); const float r = 1.f / sqrtf(ss * (1.f / 128.f) + 1e-6f);
        const unsigned g = *(const GAS unsigned*)(RGs + (size_t)(rowb + i) * 512 + h * 128 + 2 * lane);
        *(GAS unsigned*)(CAT + (size_t)(rowb + i) * 1024 + 512 + h * 128 + 2 * lane) = pk2(ov.x * r * bflo(g), ov.y * r * bfhi(g)); }
}

#define PHASE_BEGIN() GAS unsigned char* wsg_ = (GAS unsigned char*)args.ws; { int t_ = threadIdx.x; asm volatile("" : "+v"(t_)); F.tid = t_; F.lane = t_ & 63; F.wave = __builtin_amdgcn_readfirstlane(t_ >> 6); asm volatile("" : "+s"(wsg_)); } \
    unsigned char* wsl = (unsigned char*)wsg_; float* out = (float*)(GAS float*)args.out; const int gw = F.vcu * NWAVES + F.wave, NGW = F.G * NWAVES, gt = F.vcu * (NWAVES * 64) + F.tid, NGT = F.G * NWAVES * 64; (void)out; (void)gw; (void)NGW; (void)gt; (void)NGT
#define AIN(i) ((const float*)(const GAS float*)args.in[i])
#define WSP(type, off) ((type*)(wsl + (off)))
struct Args { const float* in[15]; float* out; unsigned char* ws; };
__global__ void __launch_bounds__(NWAVES * 64, 2) hymba_fwd(Args args) {
    extern __shared__ __attribute__((aligned(16))) unsigned char lds[];
    Frame F;
    F.lds = (LAS unsigned char*)lds;
    F.MISC = (volatile LAS unsigned*)(F.lds + MISC_OFF);
    F.tid = threadIdx.x; F.lane = F.tid & 63; F.wave = __builtin_amdgcn_readfirstlane(F.tid >> 6);
    F.G = gridDim.x; { const int bx = blockIdx.x; F.vcu = (F.G % 8 == 0) ? (bx % 8) * (F.G / 8) + bx / 8 : bx; }
    F.ctl = (gu32*)(args.ws + WS_CTL);
    for (int u = F.tid; u < (LDS_BYTES - LDSCTL_OFF) / 4; u += NWAVES * 64) ((LAS unsigned*)(F.lds + LDSCTL_OFF))[u] = 0u;
    __syncthreads();
    XcdBarrier bar = xcd_barrier_post((unsigned*)(F.ctl + CW_BAR), F.MISC + 8);

#if PH_HI > 0
    {
        PHASE_BEGIN();
        float* cosd = WSP(float, TAB_COSD); float* sind = WSP(float, TAB_SIND); float* cosr = WSP(float, TAB_COSR); float* sinr = WSP(float, TAB_SINR);
        for (int rep = 0; rep < REP_P0; ++rep) {
        for (int e = gt; e < 8192 * 40; e += NGT) { const int pos = e / 40, f = e % 40; float s, c;
            if (f < 8) { sincos_d((double)pos * INV_D[f], s, c); cosd[pos * 8 + f] = c; sind[pos * 8 + f] = s; }
            else { sincos_d((double)pos * INV_R[f - 8], s, c); cosr[pos * 32 + f - 8] = c; sinr[pos * 32 + f - 8] = s; } }
        LAS float* scr = (LAS float*)(F.lds + RING_OFF + F.wave * 16384);
        constexpr int I_IN = (DM / 64) * (NIN / 32), I_OUT = (DM / 64) * (DM / 32), I_UP = (DM / 64) * (NUP / 32), I_DN = (DFF / 64) * (DM / 32);
        for (int it = gw; it < I_IN + I_OUT + I_UP + I_DN; it += NGW) {
            int r = it;
            if (r < I_IN) { p0_transpose_item<1>(AIN(7), DM, NIN, WSP(bf16, WS_WIN), nullptr, scr, r, F.lane); continue; } r -= I_IN;
            if (r < I_OUT) { p0_transpose_item<0>(AIN(10), DM, DM, WSP(bf16, WS_WOUT), nullptr, scr, r, F.lane); continue; } r -= I_OUT;
            if (r < I_UP) { p0_transpose_item<2>(AIN(12), DM, NUP, WSP(bf16, WS_WUP), AIN(11), scr, r, F.lane); continue; } r -= I_UP;
            p0_transpose_item<0>(AIN(13), DFF, DM, WSP(bf16, WS_WDN), nullptr, scr, r, F.lane);
        }
        const float* x_prompt = AIN(0); const float* x_sample = AIN(1); bf16* XN = WSP(bf16, WS_XN);
        for (int m = gw; m < MT; m += NGW) rms_row_to_bf16(F.lane, m < MP ? x_prompt + (size_t)m * DM : x_sample + (size_t)(m - MP) * DM, AIN(6), XN + (size_t)m * DM);
        }
        xcd_barrier(bar);
    }
#endif
#if PH_HI > 1
    {
        PHASE_BEGIN();
        pg8::Gemm g{WSP(bf16, WS_XN), WSP(bf16, WS_WIN), MP, NIN, DM}; pg8::StaticOrder S; S.init(MP, NIN, F.G, (int)blockIdx.x);
        pg8::EpiInProj E{WSP(bf16, WS_DQ), WSP(bf16, WS_DK), WSP(bf16, WS_DV), WSP(bf16, WS_RQ), WSP(bf16, WS_RK), WSP(bf16, WS_RV), WSP(bf16, WS_RG), out,
                         WSP(float, TAB_COSD), WSP(float, TAB_SIND), WSP(float, TAB_COSR), WSP(float, TAB_SINR)};
        for (int rep = 0; rep < REP_P1; ++rep)
        pg8::gemm_phase<pg8::EpiInProj, pg8::StaticOrder, true, true>(F.lds + RING_OFF, g, S, E);
        pg8::skinny_phase(WSP(bf16, WS_XN) + (size_t)MP * DM, WSP(bf16, WS_WIN), DM, NIN, MP, E, F.vcu, F.G);
        xcd_barrier(bar);
    }
#endif
#if PH_HI > 2
    {
        PHASE_BEGIN();
        for (int rep = 0; rep < REP_P2A; ++rep)
        for (int vv = F.vcu; vv < 256; vv += F.G) {
            const int hm = (vv >> 4) & 15, s = vv & 15, b = hm >> 3, h = (hm >> 1) & 3, m = hm & 1;
            bf16* DQ = WSP(bf16, WS_DQ); bf16* DK = WSP(bf16, WS_DK); bf16* DV = WSP(bf16, WS_DV); bf16* OA = WSP(bf16, WS_OA);
            att::BlockRef r0, r1;
            const size_t rb = (size_t)b * SEQ;
            r0.Q = DQ + (rb + (size_t)s * 256) * 512 + (h * 2 + m) * 64; r0.K = DK + rb * 512 + (h * 2 + m) * 64; r0.V = DV + rb * 512 + h * 128;
            r0.O = OA + (rb + (size_t)s * 256) * 1024 + (h * 2 + m) * 128; r0.P0 = s * 256;
            r1 = r0; r1.Q = DQ + (rb + (size_t)(31 - s) * 256) * 512 + (h * 2 + m) * 64; r1.O = OA + (rb + (size_t)(31 - s) * 256) * 1024 + (h * 2 + m) * 128; r1.P0 = (31 - s) * 256;
            att::Seam S;
            att::attn_prime(r0, (char*)lds + RING_OFF, S);
            att::attn_block(r0, r1, (char*)lds + RING_OFF, S);
            att::attn_block(r1, r1, (char*)lds + RING_OFF, S);
        }
        VM_WAIT(); __syncthreads();
    }
    {
        PHASE_BEGIN();
        LAS float* scr = (LAS float*)(F.lds + RING_OFF) + F.wave * 1024;
        const float* cache_k = AIN(2); const float* cache_v = AIN(3); const int* page_table = (const int*)AIN(5);
        for (int rep = 0; rep < REP_P2B; ++rep)
        for (int it = gw; it < DEC_B * N_ITEMS; it += NGW) {
            int db, pg; if (it < DEC_B * N_PAGES) { db = it >> 4; pg = it & 15; } else { db = it - DEC_B * N_PAGES; pg = N_PAGES; }
            const float* Kb; const float* Vb; int ntok;
            if (pg < N_PAGES) { const int phys = __builtin_amdgcn_readfirstlane(page_table[db * N_PAGES + pg]); Kb = cache_k + (size_t)phys * PAGE * 512; Vb = cache_v + (size_t)phys * PAGE * 512; ntok = PAGE; }
            else { Kb = out + pg8::OFF_KS + (size_t)db * 4 * 512; Vb = out + pg8::OFF_VS + (size_t)db * 4 * 512; ntok = DEC_T; }
            const int item = db * N_ITEMS + pg;
            decode_item(Kb, Vb, ntok, pg == N_PAGES, WSP(bf16, WS_DQ) + (size_t)(MP + db * 4) * 512, scr, WSP(float, WS_DECO) + (size_t)item * 4096, WSP(float, WS_DECML) + (size_t)item * 64, F.lane);
        }
        __syncthreads();
    }
    {
        PHASE_BEGIN();
        for (int rep = 0; rep < REP_P2C; ++rep) {
        for (int u = F.vcu; u < 512; u += F.G) ret_kv_unit(F, u >> 6, u & 63, WSP(bf16, WS_RK), WSP(bf16, WS_RV), WSP(float, WS_KV));
        for (int it = gw; it < DEC_B * 4; it += NGW) sample_ret_item(it >> 2, it & 3, F.lane, WSP(bf16, WS_RQ), WSP(bf16, WS_RK), WSP(bf16, WS_RV), WSP(bf16, WS_RG), AIN(4), out + pg8::OFF_RS, WSP(bf16, WS_CAT));
        }
        xcd_barrier(bar);
    }
#endif
#if PH_HI > 3
    {
        PHASE_BEGIN();
        for (int rep = 0; rep < REP_P3; ++rep) {
        { float* KV = WSP(float, WS_KV); bf16* ST = WSP(bf16, WS_ST);
        for (int e = gt; e < 8 * 8192; e += NGT) { const int bh = e >> 13, idx = e & 8191, h = bh & 3; const float gc = __builtin_amdgcn_exp2f(log2_gamma(h) * 128.f);
            float s = 0.f; const float* kv = KV + (size_t)bh * 64 * 8192 + idx; bf16* st = ST + (size_t)bh * 64 * 8192 + idx;
#pragma unroll 8
            for (int c = 0; c < 64; ++c) { st[(size_t)c * 8192] = (bf16)f2bf(s); s = s * gc + kv[(size_t)c * 8192]; }
            const int ee = idx >> 6, d = idx & 63; out[pg8::OFF_RP + (size_t)bh * 8192 + d * 128 + ee] = s; } }
        const float* diff_lambda = AIN(8); const float* subln_g = AIN(9);
        bf16* OA = WSP(bf16, WS_OA); bf16* CAT = WSP(bf16, WS_CAT); float* DECO = WSP(float, WS_DECO); float* DECML = WSP(float, WS_DECML);
        float lam;
        { const float a = diff_lambda[F.lane] * diff_lambda[64 + F.lane], bq = diff_lambda[128 + F.lane] * diff_lambda[192 + F.lane];
          lam = __expf(wave_sum(a)) - __expf(wave_sum(bq)) + 0.2f; }
        const int hh = F.lane >> 4, ch = F.lane & 15;
        f32x4 sg0 = *(const f32x4*)(subln_g + ch * 8), sg1 = *(const f32x4*)(subln_g + ch * 8 + 4);
        for (int row = gw; row < MP; row += NGW) {
            const v4u a = *(const GAS v4u*)(OA + (size_t)row * 1024 + (hh * 2) * 128 + ch * 8), bq = *(const GAS v4u*)(OA + (size_t)row * 1024 + (hh * 2 + 1) * 128 + ch * 8);
            float d[8]; const unsigned aw[4] = {a.x, a.y, a.z, a.w}, bw[4] = {bq.x, bq.y, bq.z, bq.w}; float ss = 0.f;
#pragma unroll
            for (int q = 0; q < 4; ++q) { d[2 * q] = bflo(aw[q]) - lam * bflo(bw[q]); d[2 * q + 1] = bfhi(aw[q]) - lam * bfhi(bw[q]); ss += d[2 * q] * d[2 * q] + d[2 * q + 1] * d[2 * q + 1]; }
            ss += __shfl_xor(ss, 1); ss += __shfl_xor(ss, 2); ss += __shfl_xor(ss, 4); ss += __shfl_xor(ss, 8);
            const float r = 0.8f / sqrtf(ss * (1.f / 128.f) + 1e-5f);
            v4u o; o.x = pk2(d[0] * r * sg0[0], d[1] * r * sg0[1]); o.y = pk2(d[2] * r * sg0[2], d[3] * r * sg0[3]); o.z = pk2(d[4] * r * sg1[0], d[5] * r * sg1[1]); o.w = pk2(d[6] * r * sg1[2], d[7] * r * sg1[3]);
            *(GAS v4u*)(CAT + (size_t)row * 1024 + hh * 128 + ch * 8) = o;
        }
        for (int it = gw; it < MS * 4; it += NGW) {
            typedef float f32x2 __attribute__((ext_vector_type(2)));
            const int srow = it >> 2, h = it & 3, db = srow >> 2, tq = srow & 3; f32x2 om[2];
#pragma unroll
            for (int m = 0; m < 2; ++m) { const int r = (h * 2 + m) * 4 + tq; float M = -1e30f;
                for (int pgi = 0; pgi < N_ITEMS; ++pgi) M = fmaxf(M, DECML[(size_t)(db * N_ITEMS + pgi) * 64 + r * 2]);
                float L = 0.f; f32x2 acc = (f32x2){0.f, 0.f};
                for (int pgi = 0; pgi < N_ITEMS; ++pgi) { const size_t item = (size_t)(db * N_ITEMS + pgi); const float w = __builtin_amdgcn_exp2f(DECML[item * 64 + r * 2] - M);
                    L += w * DECML[item * 64 + r * 2 + 1]; acc += *(const f32x2*)(DECO + item * 4096 + r * 128 + 2 * F.lane) * w; }
                om[m] = acc * (1.f / L); }
            const f32x2 dd = om[0] - om[1] * lam;
            const float ss = wave_sum(dd.x * dd.x + dd.y * dd.y); const float r = 0.8f / sqrtf(ss * (1.f / 128.f) + 1e-5f);
            *(GAS unsigned*)(CAT + (size_t)(MP + srow) * 1024 + h * 128 + 2 * F.lane) = pk2(dd.x * r * subln_g[2 * F.lane], dd.y * r * subln_g[2 * F.lane + 1]);
        }
        }
        xcd_barrier(bar);
    }
#endif
#if PH_HI > 4
    {
        PHASE_BEGIN();
        for (int rep = 0; rep < REP_P4; ++rep)
        for (int u = F.vcu; u < 512; u += F.G) ret_out_unit(F, u >> 6, u & 63, WSP(bf16, WS_RQ), WSP(bf16, WS_RK), WSP(bf16, WS_RV), WSP(bf16, WS_RG), WSP(bf16, WS_ST), WSP(bf16, WS_CAT));
        xcd_barrier(bar);
    }
#endif
#if PH_HI > 5
    {
        PHASE_BEGIN();
        pg8::Gemm g{WSP(bf16, WS_CAT), WSP(bf16, WS_WOUT), MP, DM, DM}; pg8::StaticOrder S; S.init(MP, DM, F.G, (int)blockIdx.x);
        pg8::EpiOutProj E{AIN(0), AIN(1), WSP(bf16, WS_X1B), WSP(float, WS_SSQ)};
        for (int rep = 0; rep < REP_P5; ++rep)
        pg8::gemm_phase<pg8::EpiOutProj, pg8::StaticOrder, true, true>(F.lds + RING_OFF, g, S, E);
        pg8::skinny_phase(WSP(bf16, WS_CAT) + (size_t)MP * DM, WSP(bf16, WS_WOUT), DM, DM, MP, E, F.vcu, F.G);
        xcd_barrier(bar);
    }
#endif
#if PH_HI > 6
    {
        PHASE_BEGIN();
        pg8::Gemm g{WSP(bf16, WS_X1B), WSP(bf16, WS_WUP), MT, NUP, DM}; pg8::StaticOrder S; S.init(MT, NUP, F.G, (int)blockIdx.x);
        pg8::EpiUp E{WSP(bf16, WS_H), WSP(float, WS_SSQ)};
        for (int rep = 0; rep < REP_P6; ++rep)
        pg8::gemm_phase<pg8::EpiUp, pg8::StaticOrder, true, true>(F.lds + RING_OFF, g, S, E);
        xcd_barrier(bar);
    }
#endif
#if PH_HI > 7
    {
        PHASE_BEGIN();
        pg8::Gemm g{WSP(bf16, WS_H), WSP(bf16, WS_WDN), MP, DM, DFF}; pg8::StaticOrder S; S.init(MP, DM, F.G, (int)blockIdx.x);
        pg8::EpiDown E{WSP(bf16, WS_X1B), out + pg8::OFF_Y};
        for (int rep = 0; rep < REP_P7; ++rep)
        pg8::gemm_phase<pg8::EpiDown, pg8::StaticOrder, true, true>(F.lds + RING_OFF, g, S, E);
        pg8::skinny_phase(WSP(bf16, WS_H) + (size_t)MP * DFF, WSP(bf16, WS_WDN), DFF, DM, MP, E, F.vcu, F.G);
        xcd_barrier(bar);
    }
#endif
#if PH_HI > 8
    {
        PHASE_BEGIN();
        const float* norm_final_g = AIN(14);
        for (int m = gw; m < MT; m += NGW) { float* yr = out + pg8::OFF_Y + (size_t)m * DM;
            GAS f32x4* xr = (GAS f32x4*)yr + F.lane; const GAS f32x4* gr = (const GAS f32x4*)norm_final_g + F.lane;
            f32x4 v[4]; float s = 0.f;
#pragma unroll
            for (int j = 0; j < 4; ++j) { v[j] = xr[64 * j]; s += (v[j].x * v[j].x + v[j].y * v[j].y) + (v[j].z * v[j].z + v[j].w * v[j].w); }
            const float r = 1.f / sqrtf(wave_sum(s) * (1.f / DM) + 1e-6f);
#pragma unroll
            for (int j = 0; j < 4; ++j) xr[64 * j] = v[j] * r * gr[64 * j]; }
    }
#endif
}

extern "C" void kernel_launch(void* const* d_in, const int* in_sizes, int n_in, void* d_out, int out_size, void* d_ws, size_t ws_size, hipStream_t stream) {
    static int grid = 0;
    if (grid == 0) {
        if (n_in != 15 || ws_size < WS_END) { fprintf(stderr, "kernel_launch: unexpected inputs (n_in %d, ws %zu)\n", n_in, ws_size); grid = -1; return; }
        int dev = 0, cus = 0, per_cu = 0;
        if (hipGetDevice(&dev) != hipSuccess || hipDeviceGetAttribute(&cus, hipDeviceAttributeMultiprocessorCount, dev) != hipSuccess) { grid = -1; return; }
        if (hipFuncSetAttribute((const void*)hymba_fwd, hipFuncAttributeMaxDynamicSharedMemorySize, LDS_BYTES) != hipSuccess) { fprintf(stderr, "kernel_launch: hipFuncSetAttribute failed\n"); grid = -1; return; }
        if (hipOccupancyMaxActiveBlocksPerMultiprocessor(&per_cu, (const void*)hymba_fwd, NWAVES * 64, LDS_BYTES) != hipSuccess || per_cu < 1) fprintf(stderr, "kernel_launch: occupancy query reports %d\n", per_cu);
        (void)hipGetLastError();
        grid = cus;
    }
    if (grid < 0) return;
    if (hipMemsetAsync((char*)d_ws + WS_CTL, 0, CTL_ZERO_BYTES, stream) != hipSuccess) return;
    Args a{};
    for (int i = 0; i < 15; ++i) a.in[i] = (const float*)d_in[i];
    a.out = (float*)d_out; a.ws = (unsigned char*)d_ws;
    hipLaunchKernelGGL(hymba_fwd, dim3(grid), dim3(NWAVES * 64), LDS_BYTES, stream, a);
}
```

```cpp
#include <hip/hip_runtime.h>
#include <cstdio>
#include <cstdint>
#ifndef PH_HI
#define PH_HI 9
#endif
#ifndef REP_P1
#define REP_P1 1
#endif
#ifndef REP_P2A
#define REP_P2A 1
#endif
#ifndef REP_P2B
#define REP_P2B 1
#endif
#ifndef REP_P5
#define REP_P5 1
#endif
#ifndef REP_P6
#define REP_P6 1
#endif
#ifndef REP_P7
#define REP_P7 1
#endif
#ifndef REP_P0
#define REP_P0 1
#endif
#ifndef REP_P2C
#define REP_P2C 1
#endif
#ifndef REP_P3
#define REP_P3 1
#endif
#ifndef REP_P4
#define REP_P4 1
#endif
#ifndef REP_BAR
#define REP_BAR 0
#endif
namespace pg8 {
#define PG8_LAS __attribute__((address_space(3)))
typedef unsigned short bf16_t;
typedef short bf16x8 __attribute__((ext_vector_type(8)));
typedef float f32x4 __attribute__((ext_vector_type(4)));
typedef unsigned u32x4 __attribute__((ext_vector_type(4)));
constexpr int BM = 256, BK = 64, HALF = 128, HTB = HALF * BK * 2  , STAGE_BYTES = 8 * HTB, NXCD = 8, WGM = 8;

__host__ __device__ __forceinline__ int lds_byte(int r, int c) { const int st = (r >> 4) * 2 + (c >> 5), rr = r & 15, cc = c & 31, ob = rr * 64 + cc * 2; return st * 1024 + (ob ^ (((ob >> 9) & 1) << 5)); }
__host__ __device__ __forceinline__ void stage_rc(int b, int& R, int& C) { const int st = b / 1024, sb = b % 1024, swz = sb ^ (((sb >> 9) & 1) << 5); R = (st >> 1) * 16 + swz / 64; C = (st & 1) * 32 + (swz % 64) / 2; }
__host__ __device__ __forceinline__ int perm32(int rho) { const int n = rho >> 4, i = rho & 15; return 8 * (i >> 2) + 4 * n + (i & 3); }

struct Unit { int pm, pn; };
struct Gemm { const bf16_t* A; const bf16_t* Bt; int M, N, K; };

struct StaticOrder {
    int nM, nN, nwg, G, c;
    __host__ __device__ void init(int M, int N, int G_, int c_) { nM = M / BM; nN = N / BM; nwg = nM * nN; G = G_; c = c_; }
    __host__ __device__ bool next(int i, Unit& u) const {
        const long L = (long)i * G + c; if (L >= nwg) return false;
        int wgid = (int)L; { const int q = nwg / NXCD, r = nwg % NXCD, xcd = wgid % NXCD, off = wgid / NXCD; wgid = (xcd < r ? xcd * (q + 1) : r * (q + 1) + (xcd - r) * q) + off; }
        const int nig = WGM * nN, gid = wgid / nig, fm = gid * WGM, gsz = (nM - fm) < WGM ? (nM - fm) : WGM;
        u.pm = fm + ((wgid % nig) % gsz); u.pn = (wgid % nig) / gsz; return true;
    }
    __device__ __forceinline__ void a_ready(const Unit&) const {}
    __device__ __forceinline__ void done(const Unit&) const {}
};

__device__ __forceinline__ unsigned cvt_pk_bf16(float lo, float hi) { unsigned r; asm volatile("v_cvt_pk_bf16_f32 %0, %1, %2" : "=v"(r) : "v"(lo), "v"(hi)); return r; }
typedef float f32x2 __attribute__((ext_vector_type(2)));
typedef unsigned u32x2 __attribute__((ext_vector_type(2)));
constexpr int MP = 16384, MS = 512, MT = MP + MS;
constexpr long OFF_Y = 0, OFF_KP = 17301504, OFF_VP = 25690112, OFF_RP = 34078720, OFF_KS = 34144256, OFF_VS = 34406400, OFF_RS = 34668544;
__device__ __forceinline__ void st4bf(bf16_t* p, f32x4 v) { u32x2 w; w.x = cvt_pk_bf16(v[0], v[1]); w.y = cvt_pk_bf16(v[2], v[3]); *(u32x2*)p = w; }
__device__ __forceinline__ void st8bf(bf16_t* p, f32x4 a, f32x4 b) { u32x4 w; w.x = cvt_pk_bf16(a[0], a[1]); w.y = cvt_pk_bf16(a[2], a[3]); w.z = cvt_pk_bf16(b[0], b[1]); w.w = cvt_pk_bf16(b[2], b[3]); *(u32x4*)p = w; }
__device__ __forceinline__ float silu1(float x) { return x * __builtin_amdgcn_rcpf(1.f + __builtin_amdgcn_exp2f(-1.4426950408889634f * x)); }
__device__ __forceinline__ f32x4 silu4(f32x4 v) { return (f32x4){silu1(v[0]), silu1(v[1]), silu1(v[2]), silu1(v[3])}; }

struct EpiInProj {
    static constexpr bool PERM = true, AFTER_DRAIN = false;
    bf16_t *DQ, *DK, *DV, *RQ, *RK, *RV, *RG; float* out; const float *cosd, *sind, *cosr, *sinr;
    __device__ __forceinline__ void elem(int row, int gc, const f32x4 v0, const f32x4 v1) const {
        const int pn = gc >> 8; const bool smp = row >= MP;
        const int pos = smp ? 2048 + ((row - MP) & 3) : (row & 8191);
        if (pn < 4) {
            const int lc = gc & 511, d8 = lc & 63; const bool isk = pn >= 2;
            bf16_t* dst = (isk ? DK : DQ) + (size_t)row * 512;
            float* kout = (smp ? out + OFF_KS - (long)MP * 512 : out + OFF_KP) + (size_t)row * 512;
            if (d8 < 16) {
                const int i0 = (d8 >> 3) * 4, c1 = (lc & ~63) + i0, c2 = c1 + 8;
                const f32x4 cs = *(const f32x4*)(cosd + pos * 8 + i0), sn = *(const f32x4*)(sind + pos * 8 + i0);
                const f32x4 o1 = v0 * cs - v1 * sn, o2 = v1 * cs + v0 * sn;
                st4bf(dst + c1, o1); st4bf(dst + c2, o2);
                if (isk) { *(f32x4*)(kout + c1) = o1; *(f32x4*)(kout + c2) = o2; }
            } else {
                st8bf(dst + lc, v0, v1);
                if (isk) { *(f32x4*)(kout + lc) = v0; *(f32x4*)(kout + lc + 4) = v1; }
            }
        } else if (pn < 6) {
            const int lc = gc - 1024;
            float* vout = (smp ? out + OFF_VS - (long)MP * 512 : out + OFF_VP) + (size_t)row * 512;
            st8bf(DV + (size_t)row * 512 + lc, v0, v1);
            *(f32x4*)(vout + lc) = v0; *(f32x4*)(vout + lc + 4) = v1;
        } else if (pn < 8) {
            const int lc = gc - (pn == 6 ? 1536 : 1792), d8 = lc & 63, i0 = (d8 >> 3) * 4, c1 = (lc & ~63) + i0, c2 = c1 + 32;
            const f32x4 cs = *(const f32x4*)(cosr + pos * 32 + i0), sn = *(const f32x4*)(sinr + pos * 32 + i0);
            f32x4 o1 = v0 * cs - v1 * sn, o2 = v1 * cs + v0 * sn;
            bf16_t* dst = (pn == 6 ? RQ : RK) + (size_t)row * 256;
            if (pn == 7) { o1 = o1 * 0.125f; o2 = o2 * 0.125f; }
            st4bf(dst + c1, o1); st4bf(dst + c2, o2);
        } else if (pn < 10) {
            st8bf(RV + (size_t)row * 512 + (gc - 2048), v0, v1);
        } else {
            st8bf(RG + (size_t)row * 512 + (gc - 2560), silu4(v0), silu4(v1));
        }
    }
    __device__ __forceinline__ void skinny(int row, int gc, const f32x4 v0, const f32x4 v1) const { elem(row, gc, v0, v1); }
    __device__ __forceinline__ void operator()(const f32x4 (&acc)[2][2][4][2], const Unit& u, int wr, int wc, int fr, int fq) const {
        const int rowt = u.pm * BM + wr * 64 + fr, colt = u.pn * 256 + wc * 32 + 8 * fq;
#pragma unroll
        for (int ai = 0; ai < 2; ++ai)
#pragma unroll
            for (int m = 0; m < 4; ++m)
#pragma unroll
                for (int bj = 0; bj < 2; ++bj) elem(rowt + ai * HALF + m * 16, colt + bj * 128, acc[ai][bj][m][0], acc[ai][bj][m][1]);
    }
};
struct EpiOutProj {
    static constexpr bool PERM = true, AFTER_DRAIN = false;
    const float* xp; const float* xs; bf16_t* X1B; float* SSQ;
    __device__ __forceinline__ float elem(int row, int gc, const f32x4 a0, const f32x4 a1) const {
        const float* xb = (row >= MP) ? xs - (long)MP * 1024 : xp;
        const size_t off = (size_t)row * 1024 + gc;
        const f32x4 v0 = a0 + *(const f32x4*)(xb + off), v1 = a1 + *(const f32x4*)(xb + off + 4);
        st8bf(X1B + off, v0, v1);
        return (v0[0] * v0[0] + v0[1] * v0[1]) + (v0[2] * v0[2] + v0[3] * v0[3]) + (v1[0] * v1[0] + v1[1] * v1[1]) + (v1[2] * v1[2] + v1[3] * v1[3]);
    }
    __device__ __forceinline__ void skinny(int row, int gc, const f32x4 v0, const f32x4 v1) const {
        float ss = elem(row, gc, v0, v1); ss += __shfl_xor(ss, 16); ss += __shfl_xor(ss, 32);
        if ((threadIdx.x & 48) == 0) SSQ[(size_t)row * 32 + (gc >> 5)] = ss;
    }
    __device__ __forceinline__ void operator()(const f32x4 (&acc)[2][2][4][2], const Unit& u, int wr, int wc, int fr, int fq) const {
        const int rowt = u.pm * BM + wr * 64 + fr, colt = u.pn * BM + wc * 32 + 8 * fq;
#pragma unroll
        for (int ai = 0; ai < 2; ++ai)
#pragma unroll
            for (int m = 0; m < 4; ++m)
#pragma unroll
                for (int bj = 0; bj < 2; ++bj) { const int row = rowt + ai * HALF + m * 16;
                    float ss = elem(row, colt + bj * HALF, acc[ai][bj][m][0], acc[ai][bj][m][1]); ss += __shfl_xor(ss, 16); ss += __shfl_xor(ss, 32);
                    if (fq == 0) SSQ[(size_t)row * 32 + u.pn * 8 + bj * 4 + wc] = ss; }
    }
};
struct EpiUp {
    static constexpr bool PERM = true, AFTER_DRAIN = false;
    bf16_t* H; const float* SSQ;
    __device__ __forceinline__ void operator()(const f32x4 (&acc)[2][2][4][2], const Unit& u, int wr, int wc, int fr, int fq) const {
        const int rowt = u.pm * BM + wr * 64 + fr, colt = u.pn * BM + wc * 32 + 8 * fq;
#pragma unroll
        for (int ai = 0; ai < 2; ++ai)
#pragma unroll
            for (int m = 0; m < 4; ++m) {
                const int row = rowt + ai * HALF + m * 16;
                const f32x4* sp = (const f32x4*)(SSQ + (size_t)row * 32 + 8 * fq);
                const f32x4 sa = sp[0] + sp[1];
                float tot = (sa[0] + sa[1]) + (sa[2] + sa[3]); tot += __shfl_xor(tot, 16); tot += __shfl_xor(tot, 32);
                const float r = 1.0f / sqrtf(tot * (1.0f / 1024.0f) + 1e-6f);
#pragma unroll
                for (int bj = 0; bj < 2; ++bj) {
                    const int f0 = (colt + bj * HALF) >> 1;
                    const f32x4 g = acc[ai][bj][m][0] * r, uu = acc[ai][bj][m][1] * r;
                    st4bf(H + (size_t)row * 2816 + f0, silu4(g) * uu);
                }
            }
    }
};
struct EpiDown {
    static constexpr bool PERM = true, AFTER_DRAIN = false;
    const bf16_t* X1B; float* Y;
    __device__ __forceinline__ void elem(int row, int gc, const f32x4 a0, const f32x4 a1) const {
        const size_t off = (size_t)row * 1024 + gc;
        const u32x4 w = *(const u32x4*)(X1B + off);
        const f32x4 r0 = (f32x4){__uint_as_float(w.x << 16), __uint_as_float(w.x & 0xffff0000u), __uint_as_float(w.y << 16), __uint_as_float(w.y & 0xffff0000u)};
        const f32x4 r1 = (f32x4){__uint_as_float(w.z << 16), __uint_as_float(w.z & 0xffff0000u), __uint_as_float(w.w << 16), __uint_as_float(w.w & 0xffff0000u)};
        *(f32x4*)(Y + off) = a0 + r0; *(f32x4*)(Y + off + 4) = a1 + r1;
    }
    __device__ __forceinline__ void skinny(int row, int gc, const f32x4 v0, const f32x4 v1) const { elem(row, gc, v0, v1); }
    __device__ __forceinline__ void operator()(const f32x4 (&acc)[2][2][4][2], const Unit& u, int wr, int wc, int fr, int fq) const {
        const int rowt = u.pm * BM + wr * 64 + fr, colt = u.pn * BM + wc * 32 + 8 * fq;
#pragma unroll
        for (int ai = 0; ai < 2; ++ai)
#pragma unroll
            for (int m = 0; m < 4; ++m)
#pragma unroll
                for (int bj = 0; bj < 2; ++bj) elem(rowt + ai * HALF + m * 16, colt + bj * HALF, acc[ai][bj][m][0], acc[ai][bj][m][1]);
    }
};
template <class Epi>
__device__ __forceinline__ void skinny_phase(const bf16_t* A  , const bf16_t* Bt, int K, int N, int row0, const Epi& E, int vcu, int G) {
    int tid_l = threadIdx.x; asm volatile("" : "+v"(tid_l));
    const int wid = __builtin_amdgcn_readfirstlane(tid_l >> 6), lane = tid_l & 63, fr = lane & 15, fq = lane >> 4;
    for (int wt = wid * G + vcu; wt < N; wt += 8 * G) {
        const int tg = wt & 31, cg = wt >> 5;
        const bf16_t* ap = A + (size_t)(16 * tg + fr) * K + 8 * fq;
        const bf16_t* b0 = Bt + (size_t)(32 * cg + perm32(fr)) * K + 8 * fq;
        const bf16_t* b1 = Bt + (size_t)(32 * cg + perm32(16 + fr)) * K + 8 * fq;
        f32x4 acc0 = (f32x4){0.f, 0.f, 0.f, 0.f}, acc1 = (f32x4){0.f, 0.f, 0.f, 0.f};
        for (int kb = 0; kb < K / 32; kb += 8) {
            bf16x8 a[8], x0[8], x1[8];
#pragma unroll
            for (int q = 0; q < 8; ++q) { a[q] = *(const bf16x8*)(ap + 32 * (kb + q)); x0[q] = *(const bf16x8*)(b0 + 32 * (kb + q)); x1[q] = *(const bf16x8*)(b1 + 32 * (kb + q)); }
#pragma unroll
            for (int q = 0; q < 8; ++q) { acc0 = __builtin_amdgcn_mfma_f32_16x16x32_bf16(x0[q], a[q], acc0, 0, 0, 0); acc1 = __builtin_amdgcn_mfma_f32_16x16x32_bf16(x1[q], a[q], acc1, 0, 0, 0); }
        }
        E.skinny(row0 + 16 * tg + fr, 32 * cg + 8 * fq, acc0, acc1);
    }
}
template <class Epi, class Sched, bool ALIGN_EPI = false, bool SP2 = false>
__device__ __forceinline__ void gemm_phase(PG8_LAS unsigned char* lds, const Gemm g, const Sched& S, const Epi& E) {
    int tid_l = threadIdx.x; asm volatile("" : "+v"(tid_l));
    const int tid = tid_l, wid = __builtin_amdgcn_readfirstlane(tid >> 6), lane = tid & 63, wr = wid >> 2, wc = wid & 3, fr = lane & 15, fq = lane >> 4;
    const int K = g.K, nt = K / BK;
    unsigned voffA[2], voffB[2];
#pragma unroll
    for (int i = 0; i < 2; ++i) { int R, C; stage_rc(tid * 16 + i * 8192, R, C); const int Rb = Epi::PERM ? ((R & ~31) + perm32(R & 31)) : R;
        voffA[i] = (unsigned)(R * K + C) * 2u; voffB[i] = (unsigned)(Rb * K + C) * 2u; }
    const size_t kstep = (size_t)(BK * 2);
    const size_t hstep = (size_t)HALF * K * 2;
    const size_t tstep = 2 * hstep;
    const unsigned ldsw = (unsigned)wid * 1024u;
    const int aoff = lds_byte(wr * 64 + fr, fq * 8), boff = lds_byte(wc * 32 + fr, fq * 8);
#define PG8_SA(b, h) (((b) * 2 + (h)) * HTB)
#define PG8_SB(b, h) ((4 + (b) * 2 + (h)) * HTB)
#define PG8_STAGE(bufoff, gbase, voff) do { _Pragma("unroll") for (int _i = 0; _i < 2; ++_i) \
        __builtin_amdgcn_global_load_lds((const unsigned*)((const char*)(gbase) + (voff)[_i]), (PG8_LAS unsigned*)(lds + (bufoff) + ldsw + _i * 8192), 16, 0, 0); } while (0)
#define PG8_LDA(dst, b, h) do { _Pragma("unroll") for (int m = 0; m < 4; ++m) _Pragma("unroll") for (int k = 0; k < 2; ++k) dst[m][k] = *(const PG8_LAS bf16x8*)(lds + PG8_SA(b, h) + aoff + m * 2048 + k * 1024); } while (0)
#define PG8_LDB(dst, b, h) do { _Pragma("unroll") for (int n = 0; n < 2; ++n) _Pragma("unroll") for (int k = 0; k < 2; ++k) dst[n][k] = *(const PG8_LAS bf16x8*)(lds + PG8_SB(b, h) + boff + n * 2048 + k * 1024); } while (0)
#define PG8_MMA(ai, bj, At, Bt) do { __builtin_amdgcn_s_setprio(1); _Pragma("unroll") for (int m = 0; m < 4; ++m) _Pragma("unroll") for (int n = 0; n < 2; ++n) _Pragma("unroll") for (int k = 0; k < 2; ++k) \
        acc[ai][bj][m][n] = __builtin_amdgcn_mfma_f32_16x16x32_bf16(Bt[n][k], At[m][k], acc[ai][bj][m][n], 0, 0, 0); __builtin_amdgcn_s_setprio(0); } while (0)
#define PG8_WAIT_V(n) asm volatile("s_waitcnt vmcnt(" #n ")" ::: "memory")
#define PG8_WAIT_L(n) asm volatile("s_waitcnt lgkmcnt(" #n ")" ::: "memory")
#define PG8_BAR __builtin_amdgcn_s_barrier()
#define PG8_SCHED __builtin_amdgcn_sched_barrier(0)
    Unit cur, nxt; int ui = 0;
    if (!S.next(0, cur)) return;
    f32x4 acc[2][2][4][2];
#pragma unroll
    for (int a = 0; a < 2; ++a)
#pragma unroll
        for (int b = 0; b < 2; ++b)
#pragma unroll
            for (int m = 0; m < 4; ++m)
#pragma unroll
                for (int n = 0; n < 2; ++n) acc[a][b][m][n] = (f32x4){0.f, 0.f, 0.f, 0.f};
    bf16x8 At[4][2], B0[2][2], B1[2][2];
    const char* cA = (const char*)g.A + (size_t)cur.pm * tstep; const char* cB = (const char*)g.Bt + (size_t)cur.pn * tstep;
    S.a_ready(cur);
    if constexpr (SP2) {
        PG8_STAGE(PG8_SB(0, 0), cB, voffB); PG8_STAGE(PG8_SB(0, 1), cB + hstep, voffB); PG8_STAGE(PG8_SA(0, 0), cA, voffA); PG8_STAGE(PG8_SA(0, 1), cA + hstep, voffA);
        if (wr == 1) PG8_BAR;
        PG8_WAIT_V(2); PG8_BAR;
        PG8_STAGE(PG8_SB(1, 0), cB + kstep, voffB); PG8_STAGE(PG8_SA(1, 0), cA + kstep, voffA); PG8_STAGE(PG8_SB(1, 1), cB + hstep + kstep, voffB);
        PG8_WAIT_V(6); PG8_BAR;
    } else {
        PG8_STAGE(PG8_SB(0, 0), cB, voffB); PG8_STAGE(PG8_SA(0, 0), cA, voffA); PG8_STAGE(PG8_SB(0, 1), cB + hstep, voffB); PG8_STAGE(PG8_SA(0, 1), cA + hstep, voffA);
        if (wr == 1) PG8_BAR;
        PG8_WAIT_V(4); PG8_BAR;
        PG8_STAGE(PG8_SB(1, 0), cB + kstep, voffB); PG8_STAGE(PG8_SA(1, 0), cA + kstep, voffA); PG8_STAGE(PG8_SB(1, 1), cB + hstep + kstep, voffB);
        PG8_WAIT_V(6); PG8_BAR;
    }
    for (;;) {
        const bool has_next = S.next(ui + 1, nxt);
        const char* nA = has_next ? (const char*)g.A + (size_t)nxt.pm * tstep : cA; const char* nB = has_next ? (const char*)g.Bt + (size_t)nxt.pn * tstep : cB;
        for (int t = 0; t < nt; t += 2) {
            const bool last = (t == nt - 2);
            const char* a1 = cA + (size_t)(t + 1) * kstep;
            const char* a2 = last ? nA : cA + (size_t)(t + 2) * kstep; const char* b2 = last ? nB : cB + (size_t)(t + 2) * kstep;
            const char* a3 = a2 + kstep; const char* b3 = b2 + kstep;
            if (last && has_next) S.a_ready(nxt);
            if constexpr (SP2) {
            PG8_LDB(B0, 0, 0); PG8_LDB(B1, 0, 1); PG8_SCHED; PG8_LDA(At, 0, 0); PG8_STAGE(PG8_SA(1, 1), a1 + hstep, voffA);
            PG8_WAIT_V(8); PG8_WAIT_L(0); PG8_BAR; PG8_MMA(0, 0, At, B0); PG8_MMA(0, 1, At, B1); PG8_BAR; PG8_SCHED;
            PG8_LDA(At, 0, 1); PG8_STAGE(PG8_SB(0, 0), b2, voffB); PG8_STAGE(PG8_SB(0, 1), b2 + hstep, voffB); PG8_STAGE(PG8_SA(0, 0), a2, voffA);
            PG8_WAIT_V(8); PG8_WAIT_L(0); PG8_BAR; PG8_MMA(1, 0, At, B0); PG8_MMA(1, 1, At, B1); PG8_BAR; PG8_SCHED;
            PG8_LDB(B0, 1, 0); PG8_LDB(B1, 1, 1); PG8_SCHED; PG8_LDA(At, 1, 0); PG8_STAGE(PG8_SA(0, 1), a2 + hstep, voffA);
            PG8_WAIT_V(8); PG8_WAIT_L(0); PG8_BAR; PG8_MMA(0, 0, At, B0); PG8_MMA(0, 1, At, B1); PG8_BAR; PG8_SCHED;
            PG8_LDA(At, 1, 1); PG8_STAGE(PG8_SB(1, 0), b3, voffB); PG8_STAGE(PG8_SB(1, 1), b3 + hstep, voffB); PG8_STAGE(PG8_SA(1, 0), a3, voffA);
            PG8_WAIT_V(8); PG8_WAIT_L(0); PG8_BAR; PG8_MMA(1, 0, At, B0); PG8_MMA(1, 1, At, B1); PG8_BAR; PG8_SCHED;
            } else {
            PG8_LDB(B0, 0, 0); PG8_SCHED; PG8_LDA(At, 0, 0); PG8_STAGE(PG8_SA(1, 1), a1 + hstep, voffA);
            PG8_WAIT_L(8); PG8_BAR; PG8_WAIT_L(0); PG8_MMA(0, 0, At, B0); PG8_BAR; PG8_SCHED;
            PG8_LDB(B1, 0, 1); PG8_STAGE(PG8_SB(0, 0), b2, voffB);
            PG8_BAR; PG8_WAIT_L(0); PG8_MMA(0, 1, At, B1); PG8_BAR;
            PG8_LDA(At, 0, 1); PG8_STAGE(PG8_SA(0, 0), a2, voffA);
            PG8_BAR; PG8_WAIT_L(0); PG8_MMA(1, 0, At, B0); PG8_BAR; PG8_SCHED;
            PG8_STAGE(PG8_SB(0, 1), b2 + hstep, voffB);
            PG8_WAIT_V(6); PG8_BAR; PG8_MMA(1, 1, At, B1); PG8_BAR;
            PG8_LDB(B0, 1, 0); PG8_SCHED; PG8_LDA(At, 1, 0); PG8_STAGE(PG8_SA(0, 1), a2 + hstep, voffA);
            PG8_WAIT_L(8); PG8_BAR; PG8_WAIT_L(0); PG8_MMA(0, 0, At, B0); PG8_BAR; PG8_SCHED;
            PG8_LDB(B1, 1, 1); PG8_STAGE(PG8_SB(1, 0), b3, voffB);
            PG8_BAR; PG8_WAIT_L(0); PG8_MMA(0, 1, At, B1); PG8_BAR;
            PG8_LDA(At, 1, 1); PG8_STAGE(PG8_SA(1, 0), a3, voffA);
            PG8_BAR; PG8_WAIT_L(0); PG8_MMA(1, 0, At, B0); PG8_BAR; PG8_SCHED;
            PG8_STAGE(PG8_SB(1, 1), b3 + hstep, voffB);
            PG8_WAIT_V(6); PG8_BAR; PG8_MMA(1, 1, At, B1); PG8_BAR;
            }
        }
        if constexpr (ALIGN_EPI) { if (wr == 0) PG8_BAR; }
        if constexpr (!Epi::AFTER_DRAIN) { E(acc, cur, wr, wc, fr, fq); S.done(cur); }
        if (!has_next) break;
#pragma unroll
        for (int a = 0; a < 2; ++a)
#pragma unroll
            for (int b = 0; b < 2; ++b)
#pragma unroll
                for (int m = 0; m < 4; ++m)
#pragma unroll
                    for (int n = 0; n < 2; ++n) acc[a][b][m][n] = (f32x4){0.f, 0.f, 0.f, 0.f};
        cur = nxt; cA = nA; cB = nB; ++ui;
        if constexpr (ALIGN_EPI) { if (wr == 1) PG8_BAR; }
    }
    PG8_WAIT_V(0);
    if constexpr (!ALIGN_EPI) { if (wr == 0) PG8_BAR; }
    PG8_BAR;
    if constexpr (Epi::AFTER_DRAIN) { E.fused(acc, cur, wr, wc, fr, fq, lds, wid, lane); S.done(cur); }
#undef PG8_SA
#undef PG8_SB
#undef PG8_STAGE
#undef PG8_LDA
#undef PG8_LDB
#undef PG8_MMA
#undef PG8_WAIT_V
#undef PG8_WAIT_L
#undef PG8_BAR
#undef PG8_SCHED
}
}
namespace att {
typedef unsigned short bf16_t;
typedef short bf16x8 __attribute__((ext_vector_type(8)));
typedef short s16x4 __attribute__((ext_vector_type(4)));
typedef float f32x16 __attribute__((ext_vector_type(16)));
typedef unsigned u32x4 __attribute__((ext_vector_type(4)));
constexpr int NW = 8, QBLK = 32, KVBLK = 64, QB = NW * QBLK;
constexpr int SHM_V = KVBLK * 128 * 2, SHM_K = KVBLK * 256;
constexpr int LDS_BYTES = 2 * SHM_V + 2 * SHM_K + NW * 64 * 4;
constexpr float SCALE = 0.125f, THR = 8.f;
constexpr int QP = 512, KP = 512, VP = 512, OP = 1024;
#define KSWZ(row, colB) ((row) * 256 + ((colB) ^ (((row) & 7) << 4)))
#define SBAR() __builtin_amdgcn_sched_barrier(0)
__device__ __forceinline__ int v_st(int k, int c) { const int kk = (k & ~0xC) | ((k & 4) << 1) | ((k & 8) >> 1); return ((kk >> 3) * 4 + (c >> 5)) * 512 + ((kk & 7) * 32 + (c & 31)) * 2; }
__device__ __forceinline__ int v_rd_base(int lane) { return ((lane & 3) << 3) | (((lane >> 2) & 3) << 6) | (((lane >> 4) & 1) << 5) | (((lane >> 5) & 1) << 8); }
constexpr int v_rd_off(int d0, int ks, int half) { return d0 * 512 + ks * 4096 + half * 2048; }
__device__ __forceinline__ int crow(int r, int hi) { return (r & 3) + 8 * (r >> 2) + 4 * hi; }
__device__ __forceinline__ unsigned cvtpk(float lo, float hi) { unsigned r; asm volatile("v_cvt_pk_bf16_f32 %0, %1, %2" : "=v"(r) : "v"(lo), "v"(hi)); return r; }
__device__ __forceinline__ bf16x8 load8(const bf16_t* p) { return *reinterpret_cast<const bf16x8*>(p); }
__device__ __forceinline__ void mask_tile(f32x16& p0, f32x16& p1, int dq) {
    const float NEG = -__builtin_inff();
#pragma unroll
    for (int r = 0; r < 16; ++r) {
        const int c = (r & 3) + 8 * (r >> 2);
        if (dq - c < 0) p0[r] = NEG;
        if (dq - c - 32 < 0) p1[r] = NEG;
    }
}
__device__ __forceinline__ void partialSM(f32x16& p0, f32x16& p1, float& m_reg, float& mn, float& alpha) {
    float pmax = p0[0];
#pragma unroll
    for (int r = 1; r < 16; ++r) pmax = fmaxf(pmax, p0[r]);
#pragma unroll
    for (int r = 0; r < 16; ++r) pmax = fmaxf(pmax, p1[r]);
    { auto rr = __builtin_amdgcn_permlane32_swap(__float_as_uint(pmax), __float_as_uint(pmax), false, false);
      pmax = fmaxf(__uint_as_float(rr[0]), __uint_as_float(rr[1])); }
    constexpr float C2 = 1.4426950408889634f * SCALE;
    if (__builtin_expect(__all((pmax - m_reg) * SCALE <= THR), 1)) { mn = m_reg; alpha = 1.f; }
    else { mn = fmaxf(m_reg, pmax); alpha = __builtin_amdgcn_exp2f((m_reg - mn) * C2); m_reg = mn; }
    const float mnL = -mn * C2;
#pragma unroll
    for (int r = 0; r < 16; ++r) p0[r] = fmaf(p0[r], C2, mnL);
#pragma unroll
    for (int r = 0; r < 16; ++r) p1[r] = fmaf(p1[r], C2, mnL);
#pragma unroll
    for (int r = 0; r < 16; ++r) p0[r] = __builtin_amdgcn_exp2f(p0[r]);
}
__device__ __forceinline__ void finishSM(f32x16& p0, f32x16& p1, float alpha, float& l_reg, bf16x8& pa0, bf16x8& pa1, bf16x8& pa2, bf16x8& pa3) {
#pragma unroll
    for (int r = 0; r < 16; ++r) p1[r] = __builtin_amdgcn_exp2f(p1[r]);
    float ps = 0;
#pragma unroll
    for (int r = 0; r < 16; ++r) ps += p0[r];
#pragma unroll
    for (int r = 0; r < 16; ++r) ps += p1[r];
    { auto rr = __builtin_amdgcn_permlane32_swap(__float_as_uint(ps), __float_as_uint(ps), false, false);
      ps = __uint_as_float(rr[0]) + __uint_as_float(rr[1]); }
    l_reg = l_reg * alpha + ps;
#define PK4(P, B_, OUT) do { unsigned a0 = cvtpk(P[B_+0], P[B_+1]), a1 = cvtpk(P[B_+2], P[B_+3]);                          \
        unsigned b0 = cvtpk(P[B_+4], P[B_+5]), b1 = cvtpk(P[B_+6], P[B_+7]);                                             \
        auto r0 = __builtin_amdgcn_permlane32_swap(a0, b0, false, false); auto r1 = __builtin_amdgcn_permlane32_swap(a1, b1, false, false); \
        u32x4 w = {r0[0], r1[0], r0[1], r1[1]}; OUT = *reinterpret_cast<bf16x8*>(&w); } while (0)
    PK4(p0, 0, pa0); PK4(p0, 8, pa1); PK4(p1, 0, pa2); PK4(p1, 8, pa3);
#undef PK4
}
template <int KB>
__device__ __forceinline__ void qkt(f32x16& p0, f32x16& p1, const char* K_lds, int r32, int hi, const bf16x8* qr) {
    p0 = f32x16{}; p1 = f32x16{};
#pragma unroll
    for (int d0 = 0; d0 < 4; ++d0) { const char* a = K_lds + KB * SHM_K + KSWZ(r32, (d0 * 16 + hi * 8) * 2);
        bf16x8 b0 = *reinterpret_cast<const bf16x8*>(a);
        bf16x8 b1 = *reinterpret_cast<const bf16x8*>(a + 32 * 256);
        p0 = __builtin_amdgcn_mfma_f32_32x32x16_bf16(b0, qr[d0], p0, 0, 0, 0);
        p1 = __builtin_amdgcn_mfma_f32_32x32x16_bf16(b1, qr[d0], p1, 0, 0, 0); }
}
template <int VB>
__device__ __forceinline__ void pv_tile(f32x16* o, int vb0, bf16x8 pa0, bf16x8 pa1, bf16x8 pa2, bf16x8 pa3) {
#define TRRD(dst, off) asm volatile("ds_read_b64_tr_b16 %0, %1 offset:%2" : "=&v"(dst) : "v"(vb0), "i"(off) : "memory")
#define PV_D0(d0) do { s16x4 l0, l1, l2, l3, h0, h1, h2, h3; constexpr int b_ = VB * SHM_V + v_rd_off(d0, 0, 0); \
        TRRD(l0, b_); TRRD(h0, b_ + 2048); TRRD(l1, b_ + 4096); TRRD(h1, b_ + 6144); TRRD(l2, b_ + 8192); TRRD(h2, b_ + 10240); TRRD(l3, b_ + 12288); TRRD(h3, b_ + 14336); \
        asm volatile("s_waitcnt lgkmcnt(0)" ::: "memory"); SBAR();   \
        o[d0] = __builtin_amdgcn_mfma_f32_32x32x16_bf16(pa0, (bf16x8){l0[0], l0[1], l0[2], l0[3], h0[0], h0[1], h0[2], h0[3]}, o[d0], 0, 0, 0);   \
        o[d0] = __builtin_amdgcn_mfma_f32_32x32x16_bf16(pa1, (bf16x8){l1[0], l1[1], l1[2], l1[3], h1[0], h1[1], h1[2], h1[3]}, o[d0], 0, 0, 0);   \
        o[d0] = __builtin_amdgcn_mfma_f32_32x32x16_bf16(pa2, (bf16x8){l2[0], l2[1], l2[2], l2[3], h2[0], h2[1], h2[2], h2[3]}, o[d0], 0, 0, 0);   \
        o[d0] = __builtin_amdgcn_mfma_f32_32x32x16_bf16(pa3, (bf16x8){l3[0], l3[1], l3[2], l3[3], h3[0], h3[1], h3[2], h3[3]}, o[d0], 0, 0, 0); } while (0)
    PV_D0(0); PV_D0(1); PV_D0(2); PV_D0(3);
#undef PV_D0
#undef TRRD
}
struct BlockRef { const bf16_t* Q; const bf16_t* K; const bf16_t* V; bf16_t* O; int P0; };
struct Seam { bf16x8 qr[4]; bf16x8 st_v0, st_v1, st_k0; };
#define VMW() asm volatile("s_waitcnt vmcnt(0)" ::: "memory")
#define VMWN(n) asm volatile("s_waitcnt vmcnt(%0)" :: "i"(n) : "memory")
#define SLOAD_H(Kp, Vp, k0) do { S.st_v0 = load8((Vp) + (size_t)((k0) + sr) * VP + sc); S.st_v1 = load8((Vp) + (size_t)((k0) + 32 + sr) * VP + sc);  \
                                 S.st_k0 = load8((Kp) + (size_t)((k0) + kr) * KP + kc); } while (0)
#define SWRITE_HK(bf) do { *(bf16x8*)(K_lds + (bf) * SHM_K + kws) = S.st_k0; } while (0)
#define SWRITE_HV(bf) do { *(bf16x8*)(V_lds + (bf) * SHM_V + vst0) = S.st_v0; *(bf16x8*)(V_lds + (bf) * SHM_V + vst1) = S.st_v1; } while (0)
#define SWRITE_H(bf) do { SWRITE_HV(bf); SWRITE_HK(bf); } while (0)
__device__ __forceinline__ void attn_prime(const BlockRef& cur, char* lds, Seam& S) {
    int tid_l = threadIdx.x; asm volatile("" : "+v"(tid_l));
    const int tid = tid_l, wid = __builtin_amdgcn_readfirstlane(tid >> 6), lane = tid & 63, r32 = lane & 31, hi = lane >> 5;
    const int sr = tid >> 4, sc = (tid & 15) * 8, kr = tid >> 3, kc = (tid & 7) * 8, kws = KSWZ(kr, kc * 2); char* K_lds = lds + 2 * SHM_V;
#pragma unroll
    for (int d0 = 0; d0 < 4; ++d0) S.qr[d0] = load8(cur.Q + (size_t)(wid * QBLK + r32) * QP + d0 * 16 + hi * 8);
    SLOAD_H(cur.K, cur.V, 0); VMW(); SWRITE_HK(0);
    __syncthreads();
}
__device__ __forceinline__ void attn_block(const BlockRef& cur, const BlockRef& nxt, char* lds, Seam& S) {
    int tid_l = threadIdx.x; asm volatile("" : "+v"(tid_l));
    const int tid = tid_l, wid = __builtin_amdgcn_readfirstlane(tid >> 6), lane = tid & 63, r32 = lane & 31, hi = lane >> 5;
    const int NT = (cur.P0 + QB) / KVBLK;
    const int qlo = cur.P0 + wid * QBLK, qm = qlo + r32 - 4 * hi;
    char* V_lds = lds; char* K_lds = lds + 2 * SHM_V;
    float* ws = (float*)(lds + 2 * SHM_V + 2 * SHM_K) + wid * 64; float* li_l = ws, * al_l = ws + 32;
    float m_reg = -1e30f, l_reg = 0; f32x16 o[4] = {};
    const int sr = tid >> 4, sc = (tid & 15) * 8, vst0 = v_st(sr, sc), vst1 = v_st(32 + sr, sc);
    const int kr = tid >> 3, kc = (tid & 7) * 8, kws = KSWZ(kr, kc * 2);
    const int vb0 = (int)(uintptr_t)V_lds + v_rd_base(lane);
    const bf16_t* Kh = cur.K; const bf16_t* Vh = cur.V;
#define RESC(a) do { if (__any((a) < 1.f)) { if (hi == 0) al_l[r32] = (a); asm volatile("s_waitcnt lgkmcnt(0)" ::: "memory");              \
                     _Pragma("unroll") for (int d_ = 0; d_ < 4; ++d_) _Pragma("unroll") for (int r = 0; r < 16; ++r) o[d_][r] *= al_l[crow(r, hi)]; } } while (0)
#define KBASE(t) ((t) * KVBLK)
#define MASKT(P0_, P1_, t) do { const int kb_ = KBASE(t); if (kb_ + KVBLK - 1 > qlo) mask_tile(P0_, P1_, qm - kb_); } while (0)
    constexpr int NQL = 4;
#define SEAM_K0() do { VMWN(NQL); SWRITE_HK(0); SBAR(); } while (0)
    f32x16 pA0, pA1, pB0, pB1; float mnA, mnB, alA, alB; bf16x8 pa0, pa1, pa2, pa3;
    SWRITE_HV(0); SBAR();
    if (NT > 1) { SLOAD_H(Kh, Vh, KBASE(1)); }
    SBAR(); qkt<0>(pA0, pA1, K_lds, r32, hi, S.qr);
    MASKT(pA0, pA1, 0); partialSM(pA0, pA1, m_reg, mnA, alA);
    if (NT > 1) { VMW(); SWRITE_H(1); }
    __syncthreads();
#define HALF_STEP(PX0, PX1, mnX, alX, PY0, PY1, alY, t, KB, VB, SB) do {                                                      \
        SBAR(); qkt<KB>(PX0, PX1, K_lds, r32, hi, S.qr);                                                                      \
        finishSM(PY0, PY1, alY, l_reg, pa0, pa1, pa2, pa3); SBAR();                                                           \
        if ((t) + 1 < NT) { SLOAD_H(Kh, Vh, KBASE((t) + 1)); SBAR(); }                                                       \
        pv_tile<VB>(o, vb0, pa0, pa1, pa2, pa3); MASKT(PX0, PX1, (t)); partialSM(PX0, PX1, m_reg, mnX, alX);                  \
        __syncthreads();                                                                                                      \
        if ((t) + 1 < NT) { VMW(); SWRITE_H(SB); }                                                                            \
        RESC(alX); __syncthreads(); } while (0)
    for (int t = 1; t + 1 < NT; t += 2) {
        HALF_STEP(pB0, pB1, mnB, alB, pA0, pA1, alA, t, 1, 0, 0);
        HALF_STEP(pA0, pA1, mnA, alA, pB0, pB1, alB, t + 1, 0, 1, 1);
    }
    const bool even = (NT & 1) == 0;
    if (even) { SBAR(); qkt<1>(pB0, pB1, K_lds, r32, hi, S.qr); SBAR(); }
    SLOAD_H(nxt.K, nxt.V, 0); SBAR();
#pragma unroll
    for (int d0 = 0; d0 < 4; ++d0) S.qr[d0] = load8(nxt.Q + (size_t)(wid * QBLK + r32) * QP + d0 * 16 + hi * 8);
    SBAR();
    finishSM(pA0, pA1, alA, l_reg, pa0, pa1, pa2, pa3); SBAR();
    pv_tile<0>(o, vb0, pa0, pa1, pa2, pa3);
    if (even) { MASKT(pB0, pB1, NT - 1); partialSM(pB0, pB1, m_reg, mnB, alB); __syncthreads(); RESC(alB);
        finishSM(pB0, pB1, alB, l_reg, pa0, pa1, pa2, pa3); SBAR(); pv_tile<1>(o, vb0, pa0, pa1, pa2, pa3); }
    SBAR(); SEAM_K0();
    if (hi == 0) li_l[r32] = l_reg; asm volatile("s_waitcnt lgkmcnt(0)" ::: "memory");
    float rli[16];
#pragma unroll
    for (int r = 0; r < 16; ++r) rli[r] = __builtin_amdgcn_rcpf(li_l[crow(r, hi)]);
    bf16_t* Ow = cur.O + (size_t)(wid * QBLK) * OP;
#pragma unroll
    for (int r = 0; r < 16; ++r) { const int orow = crow(r, hi);
#pragma unroll
        for (int d0 = 0; d0 < 4; ++d0) { const float v = o[d0][r] * rli[r];
            const float vn = __shfl_xor(v, 1);
            if ((r32 & 1) == 0) *(unsigned*)(Ow + (size_t)orow * OP + d0 * 32 + r32) = cvtpk(v, vn); } }
    __syncthreads();
#undef RESC
#undef KBASE
#undef MASKT
#undef SEAM_K0
#undef HALF_STEP
}
#undef VMW
#undef VMWN
#undef SLOAD_H
#undef SWRITE_HK
#undef SWRITE_HV
#undef SWRITE_H
#undef KSWZ
#undef SBAR
}
#define GAS __attribute__((address_space(1)))
#define LAS __attribute__((address_space(3)))
typedef unsigned short bf16;
typedef unsigned v4u __attribute__((ext_vector_type(4)));
typedef float f32x4 __attribute__((ext_vector_type(4)));
typedef short bf16x8 __attribute__((ext_vector_type(8)));
typedef GAS unsigned gu32;
typedef GAS unsigned long long gu64;
#define RLX_AGENT __ATOMIC_RELAXED, __HIP_MEMORY_SCOPE_AGENT
#define LDS_WAIT() asm volatile("s_waitcnt lgkmcnt(0)" ::: "memory")
#define VM_WAIT() asm volatile("s_waitcnt vmcnt(0)" ::: "memory")
__device__ __forceinline__ unsigned long long rt() { return __builtin_amdgcn_s_memrealtime(); }
__device__ __forceinline__ unsigned f2bf(float f) { unsigned u = __builtin_bit_cast(unsigned, f); return (u + 0x7fffu + ((u >> 16) & 1u)) >> 16; }
__device__ __forceinline__ unsigned pk2(float lo, float hi) { return f2bf(lo) | (f2bf(hi) << 16); }

#define XB_TMO      128
#define XB_XCNT(j)  (256  + 64 * (j))
#define XB_XSUB(j)  (1280 + 64 * (j))
#define XB_XGEN(j)  (2304 + 64 * (j))
#define XB_TOP      3328
#define XB_TOPGEN   3392
#define XCD_BAR_WORDS 3456
#define XB_SPIN_CAP (1u << 18)

__device__ __forceinline__ unsigned xb_ld(unsigned* p)              { return __hip_atomic_load(p, __ATOMIC_RELAXED, __HIP_MEMORY_SCOPE_AGENT); }
__device__ __forceinline__ unsigned xb_add(unsigned* p, unsigned v) { return __hip_atomic_fetch_add(p, v, __ATOMIC_RELAXED, __HIP_MEMORY_SCOPE_AGENT); }
__device__ __forceinline__ unsigned xb_xcc_id() { return (unsigned)__builtin_amdgcn_s_getreg((3 << 11) | 20) & 0xFu; }
#define XB_SPIN(cond, bar) do { unsigned _sp = 0; while (cond) { __builtin_amdgcn_s_sleep(1); \
    if ((++_sp & 255u) == 0u) { if (xb_ld(&(bar)[XB_TMO])) break; if (_sp > XB_SPIN_CAP) { atomicAdd(&(bar)[XB_TMO], 1u); break; } } } } while (0)

struct XcdBarrier {
    unsigned* bar; unsigned x;
    volatile LAS unsigned* st;
};

__device__ __forceinline__ XcdBarrier xcd_barrier_post(unsigned* bar, volatile LAS unsigned* st) {
    XcdBarrier b; b.bar = bar; b.x = xb_xcc_id(); b.st = st;
    if (threadIdx.x == 0) (void)xb_add(&bar[XB_XCNT(b.x)], 1u);
    return b;
}
__device__ __forceinline__ void xcd_barrier_complete(unsigned* bar, unsigned x, unsigned& nloc, unsigned& nx) {
    const unsigned G = gridDim.x * gridDim.y * gridDim.z;
    unsigned sum, cnt, mine, sp = 0u;
    for (;;) {
        sum = 0u; cnt = 0u; mine = 0u;
#pragma unroll
        for (unsigned j = 0; j < 16; ++j) { const unsigned c = xb_ld(&bar[XB_XCNT(j)]); sum += c; cnt += (c > 0u) ? 1u : 0u; mine = (j == x) ? c : mine; }
        if (sum == G) break;
        __builtin_amdgcn_s_sleep(1);
        if ((++sp & 255u) == 0u) { if (xb_ld(&bar[XB_TMO])) break; if (sp > XB_SPIN_CAP) { atomicAdd(&bar[XB_TMO], 1u); break; } }
    }
    nloc = mine > 0u ? mine : 1u; nx = cnt > 0u ? cnt : 1u;
}

__device__ __forceinline__ void xcd_barrier(const XcdBarrier& b) {
    asm volatile("s_waitcnt vmcnt(0)" ::: "memory");
    __syncthreads();
    if (threadIdx.x == 0) {
        unsigned* bar = b.bar;
        __builtin_amdgcn_s_waitcnt(0);
        unsigned nloc = b.st[0], nx = b.st[1];
        if (nloc == 0u) { xcd_barrier_complete(bar, b.x, nloc, nx); b.st[0] = nloc; b.st[1] = nx; }
        const unsigned old = xb_add(&bar[XB_XSUB(b.x)], 1u);
        const unsigned gen = old / nloc;
        if (old + 1u == (gen + 1u) * nloc) {
            __builtin_amdgcn_fence(__ATOMIC_RELEASE, "agent");
            asm volatile("s_waitcnt vmcnt(0)" ::: "memory");
            const unsigned og = xb_add(&bar[XB_TOP], 1u);
            const unsigned tg = og / nx;
            if (og + 1u == (tg + 1u) * nx) xb_add(&bar[XB_TOPGEN], 1u);
            else XB_SPIN(xb_ld(&bar[XB_TOPGEN]) == tg, bar);
            __builtin_amdgcn_fence(__ATOMIC_ACQUIRE, "agent");
            xb_add(&bar[XB_XGEN(b.x)], 1u);
            asm volatile("s_waitcnt vmcnt(0)" ::: "memory");
        } else {
            XB_SPIN(xb_ld(&bar[XB_XGEN(b.x)]) == gen, bar);
            __builtin_amdgcn_fence(__ATOMIC_ACQUIRE, "agent");
            asm volatile("s_waitcnt vmcnt(0)" ::: "memory");
        }
    }
    __syncthreads();
}
constexpr int NWAVES = 8;
constexpr int DM = 1024, MP = pg8::MP, MS = pg8::MS, MT = pg8::MT, SEQ = 8192, NIN = 3072, DFF = 2816, NUP = 2 * DFF;
constexpr int DEC_B = 128, DEC_T = 4, N_PAGES = 16, PAGE = 128, N_ITEMS = 17;
constexpr size_t MiB = 1u << 20;
constexpr size_t WS_CTL = 0, CTL_ZERO_BYTES = 1 * MiB;
constexpr size_t WS_TAB = 1 * MiB;
constexpr size_t TAB_COSD = WS_TAB, TAB_SIND = TAB_COSD + 262144, TAB_COSR = TAB_SIND + 262144, TAB_SINR = TAB_COSR + 1048576;
constexpr size_t WS_WIN = 4 * MiB, WS_WOUT = 10 * MiB, WS_WUP = 12 * MiB, WS_WDN = 23 * MiB;
constexpr size_t WS_XN = 32 * MiB;
constexpr size_t WS_DQ = 66 * MiB, WS_DK = 83 * MiB, WS_DV = 100 * MiB, WS_RV = 117 * MiB, WS_RG = 134 * MiB;
constexpr size_t WS_RQ = 151 * MiB, WS_RK = 160 * MiB;
constexpr size_t WS_OA = 169 * MiB;
constexpr size_t WS_CAT = 202 * MiB;
constexpr size_t WS_DECO = 236 * MiB;
constexpr size_t WS_DECML = 271 * MiB;
constexpr size_t WS_KV = 272 * MiB;
constexpr size_t WS_ST = 288 * MiB;
constexpr size_t WS_X1 = 296 * MiB;
constexpr size_t WS_X1B = 362 * MiB;
constexpr size_t WS_SSQ = 395 * MiB;
constexpr size_t WS_H = 398 * MiB;
constexpr size_t WS_END = 489 * MiB;
constexpr int CW_TMO = 0, CW_CODE = 1, CW_BAR = 4096;
constexpr int RING_OFF = 0, RING_BYTES = 131072;
constexpr int LDSCTL_OFF = RING_BYTES, MISC_OFF = LDSCTL_OFF + 320;
constexpr int LDS_BYTES = 147456;
static_assert(att::LDS_BYTES <= RING_BYTES && pg8::STAGE_BYTES <= RING_BYTES, "LDS map");

__constant__ double INV_D[8] = {1, 0.19392274474868576, 0.037606030930863933, 0.0072926647372171093, 0.001414213562373095, 0.0002742481756762073, 5.3182958969449883e-05, 1.031338537721246e-05};
__constant__ double INV_R[32] = {1, 0.74989420933245587, 0.56234132519034907, 0.42169650342858223, 0.31622776601683794, 0.23713737056616552, 0.17782794100389229, 0.1333521432163324, 0.10000000000000001, 0.074989420933245579, 0.056234132519034911, 0.042169650342858224, 0.031622776601683791, 0.023713737056616554, 0.017782794100389229, 0.013335214321633241, 0.01, 0.0074989420933245579, 0.005623413251903491, 0.0042169650342858229, 0.0031622776601683794, 0.0023713737056616554, 0.0017782794100389228, 0.0013335214321633241, 0.001, 0.00074989420933245586, 0.0005623413251903491, 0.00042169650342858224, 0.00031622776601683794, 0.00023713737056616554, 0.00017782794100389227, 0.0001333521432163324};
__device__ __forceinline__ float log2_gamma(int h) { return h == 0 ? -0.045803689613124789f : h == 1 ? -0.022720076500083529f : h == 2 ? -0.011315313227834146f : -0.0056465631411420627f; }

struct Frame {
    LAS unsigned char* lds;
    volatile LAS unsigned* MISC;
    gu32* ctl;
    int tid, lane, wave, vcu, G;
};
__device__ __forceinline__ float wave_sum(float v) {
#pragma unroll
    for (int o = 1; o < 64; o <<= 1) v += __shfl_xor(v, o);
    return v;
}
__device__ __forceinline__ float bf2f(bf16 b) { return __uint_as_float((unsigned)b << 16); }
__device__ __forceinline__ float bflo(unsigned w) { return __uint_as_float(w << 16); }
__device__ __forceinline__ float bfhi(unsigned w) { return __uint_as_float(w & 0xffff0000u); }

__device__ __forceinline__ int perm_in(int n) {
    if (n < 1024) { const int d = n & 63; if (d < 16) { const int i = d & 7, half = d >> 3; return (n & ~63) + ((i >> 2) << 3) + (half << 2) + (i & 3); } return n; }
    if (n >= 1536 && n < 2048) { const int d = n & 63, i = d & 31, half = d >> 5; return (n & ~63) + ((i >> 2) << 3) + (half << 2) + (i & 3); }
    return n;
}
__device__ __forceinline__ int perm_up(int n) { const int part = n >= DFF ? 1 : 0, f = part ? n - DFF : n; return ((f >> 2) << 3) + (part << 2) + (f & 3); }
template <int PERM>
__device__ __forceinline__ void p0_transpose_item(const float* W, int K, int N, bf16* WT, const float* gain, LAS float* scr, int item, int lane) {
    const int nblk = N / 32, kb = item / nblk, nb = item % nblk, k0 = 64 * kb, n0 = 32 * nb;
#pragma unroll
    for (int i = 0; i < 8; ++i) { const int kk = 8 * i + (lane >> 3), nq = (lane & 7) * 4;
        f32x4 w = *(const GAS f32x4*)(W + (size_t)(k0 + kk) * N + n0 + nq); if (gain) w = w * gain[k0 + kk];
        scr[kk * 33 + nq] = w[0]; scr[kk * 33 + nq + 1] = w[1]; scr[kk * 33 + nq + 2] = w[2]; scr[kk * 33 + nq + 3] = w[3]; }
    LDS_WAIT(); asm volatile("" ::: "memory");
    const int c = lane & 7;
#pragma unroll
    for (int j = 0; j < 4; ++j) { const int n = (lane >> 3) + 8 * j; const LAS float* s = scr + (8 * c) * 33 + n;
        v4u o; o.x = pk2(s[0 * 33], s[1 * 33]); o.y = pk2(s[2 * 33], s[3 * 33]); o.z = pk2(s[4 * 33], s[5 * 33]); o.w = pk2(s[6 * 33], s[7 * 33]);
        const int nl = n0 + n, np = PERM == 1 ? perm_in(nl) : PERM == 2 ? perm_up(nl) : nl;
        *(GAS v4u*)(WT + (size_t)np * K + k0 + 8 * c) = o; }
    LDS_WAIT(); asm volatile("" ::: "memory");
}
__device__ __forceinline__ void rms_row_to_bf16(int lane, const float* xrow, const float* g, bf16* orow) {
    const GAS f32x4* xr = (const GAS f32x4*)xrow + lane; const GAS f32x4* gr = (const GAS f32x4*)g + lane;
    f32x4 v[4]; float s = 0.f;
#pragma unroll
    for (int j = 0; j < 4; ++j) { v[j] = xr[64 * j]; s += (v[j].x * v[j].x + v[j].y * v[j].y) + (v[j].z * v[j].z + v[j].w * v[j].w); }
    const float r = 1.f / sqrtf(wave_sum(s) * (1.f / DM) + 1e-6f);
    GAS unsigned long long* o8 = (GAS unsigned long long*)orow + lane;
#pragma unroll
    for (int j = 0; j < 4; ++j) { const f32x4 gg = gr[64 * j]; o8[64 * j] = (unsigned long long)pk2(v[j].x * r * gg.x, v[j].y * r * gg.y) | ((unsigned long long)pk2(v[j].z * r * gg.z, v[j].w * r * gg.w) << 32); }
}
__device__ __forceinline__ void rms_row2_to_bf16(int lane, const float* xa, const float* xb, bool hasb, const float* g, bf16* oa, bf16* ob) {
    const GAS f32x4* ra = (const GAS f32x4*)xa + lane; const GAS f32x4* rb = (const GAS f32x4*)(hasb ? xb : xa) + lane; const GAS f32x4* gr = (const GAS f32x4*)g + lane;
    f32x4 va[4], vb[4], gg[4]; float sa = 0.f, sb = 0.f;
#pragma unroll
    for (int j = 0; j < 4; ++j) { va[j] = ra[64 * j]; vb[j] = rb[64 * j]; gg[j] = gr[64 * j]; }
#pragma unroll
    for (int j = 0; j < 4; ++j) { sa += (va[j].x * va[j].x + va[j].y * va[j].y) + (va[j].z * va[j].z + va[j].w * va[j].w); sb += (vb[j].x * vb[j].x + vb[j].y * vb[j].y) + (vb[j].z * vb[j].z + vb[j].w * vb[j].w); }
    const float r1 = 1.f / sqrtf(wave_sum(sa) * (1.f / DM) + 1e-6f), r2 = 1.f / sqrtf(wave_sum(sb) * (1.f / DM) + 1e-6f);
    GAS unsigned long long* o1 = (GAS unsigned long long*)oa + lane; GAS unsigned long long* o2 = (GAS unsigned long long*)ob + lane;
#pragma unroll
    for (int j = 0; j < 4; ++j) { o1[64 * j] = (unsigned long long)pk2(va[j].x * r1 * gg[j].x, va[j].y * r1 * gg[j].y) | ((unsigned long long)pk2(va[j].z * r1 * gg[j].z, va[j].w * r1 * gg[j].w) << 32);
        if (hasb) o2[64 * j] = (unsigned long long)pk2(vb[j].x * r2 * gg[j].x, vb[j].y * r2 * gg[j].y) | ((unsigned long long)pk2(vb[j].z * r2 * gg[j].z, vb[j].w * r2 * gg[j].w) << 32); }
}
__device__ __forceinline__ void sincos_d(double x, float& s, float& c) {
    const double k = __builtin_rint(x * 0.63661977236758134308);
    double r = __builtin_fma(-k, 1.57079632679489655800e+00, x); r = __builtin_fma(-k, 6.12323399573676603587e-17, r);
    const double r2 = r * r;
    const double sp = r * (1.0 + r2 * (-1.0 / 6 + r2 * (1.0 / 120 + r2 * (-1.0 / 5040 + r2 * (1.0 / 362880 + r2 * (-1.0 / 39916800 + r2 * (1.0 / 6227020800.0)))))));
    const double cp = 1.0 + r2 * (-0.5 + r2 * (1.0 / 24 + r2 * (-1.0 / 720 + r2 * (1.0 / 40320 + r2 * (-1.0 / 3628800 + r2 * (1.0 / 479001600.0 + r2 * (-1.0 / 87178291200.0)))))));
    const int q = ((int)k) & 3;
    const double ss = (q == 0) ? sp : (q == 1) ? cp : (q == 2) ? -sp : -cp;
    const double cc = (q == 0) ? cp : (q == 1) ? -sp : (q == 2) ? -cp : sp;
    s = (float)ss; c = (float)cc;
}

typedef float f32x4m __attribute__((ext_vector_type(4)));
__device__ __forceinline__ bf16x8 lfrag(const LAS unsigned char* base, int row, int ldb, int kbyte) { return *(const LAS bf16x8*)(base + row * ldb + kbyte); }
#define MFMA16(a, b, c) __builtin_amdgcn_mfma_f32_16x16x32_bf16((a), (b), (c), 0, 0, 0)

constexpr int LDT = 136 * 2;
constexpr int LDH = 72 * 2;
__device__ __forceinline__ void ret_kv_unit(Frame& F, int bh, int c, const bf16* RK, const bf16* RV, float* KV) {
    LAS unsigned char* VT = F.lds;
    LAS unsigned char* KT = F.lds + 128 * LDT;
    const int b = bh >> 2, h = bh & 3; const size_t R0 = (size_t)b * SEQ + (size_t)c * 128;
    const float lg = log2_gamma(h);
    for (int idx = F.tid; idx < 2048; idx += 512) { const int j = idx & 127, ec = idx >> 7;
        const v4u w = *(const GAS v4u*)(RV + (R0 + j) * 512 + h * 128 + ec * 8);
        const unsigned ww[4] = {w.x, w.y, w.z, w.w};
#pragma unroll
        for (int q = 0; q < 4; ++q) { *(LAS bf16*)(VT + (ec * 8 + 2 * q) * LDT + j * 2) = (bf16)(ww[q] & 0xffffu); *(LAS bf16*)(VT + (ec * 8 + 2 * q + 1) * LDT + j * 2) = (bf16)(ww[q] >> 16); } }
    for (int idx = F.tid; idx < 1024; idx += 512) { const int j = idx & 127, dc = idx >> 7;
        const v4u w = *(const GAS v4u*)(RK + (R0 + j) * 256 + h * 64 + dc * 8);
        const float dec = __builtin_amdgcn_exp2f(lg * (float)(127 - j));
        const unsigned ww[4] = {w.x, w.y, w.z, w.w};
#pragma unroll
        for (int q = 0; q < 4; ++q) { *(LAS bf16*)(KT + (dc * 8 + 2 * q) * LDT + j * 2) = (bf16)f2bf(bflo(ww[q]) * dec); *(LAS bf16*)(KT + (dc * 8 + 2 * q + 1) * LDT + j * 2) = (bf16)f2bf(bfhi(ww[q]) * dec); } }
    LDS_WAIT(); __syncthreads();
    const int fr = F.lane & 15, fq = F.lane >> 4, w = F.wave;
    f32x4m acc[4];
#pragma unroll
    for (int nj = 0; nj < 4; ++nj) acc[nj] = (f32x4m){0.f, 0.f, 0.f, 0.f};
#pragma unroll
    for (int ks = 0; ks < 4; ++ks) { const bf16x8 a = lfrag(VT, 16 * w + fr, LDT, (32 * ks + 8 * fq) * 2);
#pragma unroll
        for (int nj = 0; nj < 4; ++nj) acc[nj] = MFMA16(a, lfrag(KT, 16 * nj + fr, LDT, (32 * ks + 8 * fq) * 2), acc[nj]); }
    float* dst = KV + ((size_t)bh * 64 + c) * 8192;
#pragma unroll
    for (int nj = 0; nj < 4; ++nj)
#pragma unroll
        for (int r = 0; r < 4; ++r) dst[(16 * w + 4 * fq + r) * 64 + 16 * nj + fr] = acc[nj][r];
    __syncthreads();
}
__device__ __forceinline__ void ret_out_unit(Frame& F, int bh, int c, const bf16* RQ, const bf16* RK, const bf16* RV, const bf16* RGs, const bf16* ST, bf16* CAT) {
    LAS unsigned char* Qs = F.lds;
    LAS unsigned char* Ks = Qs + 128 * LDH;
    LAS unsigned char* VT = Ks + 128 * LDH;
    LAS unsigned char* STs = VT + 128 * LDT;
    LAS unsigned char* Ps = STs + 128 * LDH;
    LAS float* OS = (LAS float*)F.lds;
    static_assert(128 * LDH * 3 + 128 * LDT * 2 <= RING_BYTES && 128 * 132 * 4 <= 128 * LDH * 2 + 128 * LDT, "retention LDS map");
    const int b = bh >> 2, h = bh & 3; const size_t R0 = (size_t)b * SEQ + (size_t)c * 128;
    const float lg = log2_gamma(h);
    for (int idx = F.tid; idx < 1024; idx += 512) { const int i = idx >> 3, ch = idx & 7;
        const v4u q = *(const GAS v4u*)(RQ + (R0 + i) * 256 + h * 64 + ch * 8);
        *(LAS v4u*)(Qs + i * LDH + ch * 16) = q;
        *(LAS v4u*)(Ks + i * LDH + ch * 16) = *(const GAS v4u*)(RK + (R0 + i) * 256 + h * 64 + ch * 8);
        *(LAS v4u*)(STs + i * LDH + ch * 16) = *(const GAS v4u*)(ST + ((size_t)bh * 64 + c) * 8192 + i * 64 + ch * 8); }
    for (int idx = F.tid; idx < 2048; idx += 512) { const int j = idx & 127, ec = idx >> 7;
        const v4u w = *(const GAS v4u*)(RV + (R0 + j) * 512 + h * 128 + ec * 8);
        const unsigned ww[4] = {w.x, w.y, w.z, w.w};
#pragma unroll
        for (int q = 0; q < 4; ++q) { *(LAS bf16*)(VT + (ec * 8 + 2 * q) * LDT + j * 2) = (bf16)(ww[q] & 0xffffu); *(LAS bf16*)(VT + (ec * 8 + 2 * q + 1) * LDT + j * 2) = (bf16)(ww[q] >> 16); } }
    LDS_WAIT(); __syncthreads();
    const int fr = F.lane & 15, fq = F.lane >> 4, w = F.wave;
    const int njmax = w | 1;
#pragma unroll
    for (int nj = 0; nj < 8; ++nj) if (nj <= njmax) {
        f32x4m s = (f32x4m){0.f, 0.f, 0.f, 0.f};
#pragma unroll
        for (int ks = 0; ks < 2; ++ks) s = MFMA16(lfrag(Qs, 16 * w + fr, LDH, (32 * ks + 8 * fq) * 2), lfrag(Ks, 16 * nj + fr, LDH, (32 * ks + 8 * fq) * 2), s);
#pragma unroll
        for (int r = 0; r < 4; ++r) { const int i = 16 * w + 4 * fq + r, j = 16 * nj + fr;
            const float p = (j <= i) ? s[r] * __builtin_amdgcn_exp2f(lg * (float)(i - j)) : 0.f;
            *(LAS bf16*)(Ps + i * LDT + j * 2) = (bf16)f2bf(p); }
    }
    LDS_WAIT(); asm volatile("" ::: "memory");
    f32x4m acc[8];
#pragma unroll
    for (int nj = 0; nj < 8; ++nj) acc[nj] = (f32x4m){0.f, 0.f, 0.f, 0.f};
    const int ksmax = w >> 1;
#pragma unroll
    for (int ks = 0; ks < 4; ++ks) if (ks <= ksmax) { const bf16x8 a = lfrag(Ps, 16 * w + fr, LDT, (32 * ks + 8 * fq) * 2);
#pragma unroll
        for (int nj = 0; nj < 8; ++nj) acc[nj] = MFMA16(a, lfrag(VT, 16 * nj + fr, LDT, (32 * ks + 8 * fq) * 2), acc[nj]); }
    const float qdec = __builtin_amdgcn_exp2f(lg * (float)(16 * w + fr + 1));
#pragma unroll
    for (int ks = 0; ks < 2; ++ks) { const v4u qq = *(const LAS v4u*)(Qs + (16 * w + fr) * LDH + (32 * ks + 8 * fq) * 2);
        v4u q2; q2.x = pk2(bflo(qq.x) * qdec, bfhi(qq.x) * qdec); q2.y = pk2(bflo(qq.y) * qdec, bfhi(qq.y) * qdec); q2.z = pk2(bflo(qq.z) * qdec, bfhi(qq.z) * qdec); q2.w = pk2(bflo(qq.w) * qdec, bfhi(qq.w) * qdec);
        const bf16x8 a = __builtin_bit_cast(bf16x8, q2);
#pragma unroll
        for (int nj = 0; nj < 8; ++nj) acc[nj] = MFMA16(a, lfrag(STs, 16 * nj + fr, LDH, (32 * ks + 8 * fq) * 2), acc[nj]); }
    float rinv[4];
#pragma unroll
    for (int r = 0; r < 4; ++r) { float ss = 0.f;
#pragma unroll
        for (int nj = 0; nj < 8; ++nj) ss += acc[nj][r] * acc[nj][r];
        ss += __shfl_xor(ss, 1); ss += __shfl_xor(ss, 2); ss += __shfl_xor(ss, 4); ss += __shfl_xor(ss, 8);
        rinv[r] = 1.f / sqrtf(ss * (1.f / 128.f) + 1e-6f); }
    __syncthreads();
#pragma unroll
    for (int nj = 0; nj < 8; ++nj)
#pragma unroll
        for (int r = 0; r < 4; ++r) OS[(16 * w + 4 * fq + r) * 132 + 16 * nj + fr] = acc[nj][r] * rinv[r];
    LDS_WAIT(); __syncthreads();
    for (int idx = F.tid; idx < 2048; idx += 512) { const int i = idx >> 4, ec = idx & 15;
        const v4u g = *(const GAS v4u*)(RGs + (R0 + i) * 512 + h * 128 + ec * 8);
        const LAS float* os = OS + i * 132 + ec * 8;
        v4u o; o.x = pk2(os[0] * bflo(g.x), os[1] * bfhi(g.x)); o.y = pk2(os[2] * bflo(g.y), os[3] * bfhi(g.y)); o.z = pk2(os[4] * bflo(g.z), os[5] * bfhi(g.z)); o.w = pk2(os[6] * bflo(g.w), os[7] * bfhi(g.w));
        *(GAS v4u*)(CAT + (R0 + i) * 1024 + 512 + h * 128 + ec * 8) = o; }
    LDS_WAIT(); __syncthreads();
}

__device__ __forceinline__ float row16_sum(float v) {
    v += __int_as_float(__builtin_amdgcn_update_dpp(0, __float_as_int(v), 0x128, 0xf, 0xf, false));
    v += __int_as_float(__builtin_amdgcn_update_dpp(0, __float_as_int(v), 0x124, 0xf, 0xf, false));
    v += __int_as_float(__builtin_amdgcn_update_dpp(0, __float_as_int(v), 0x122, 0xf, 0xf, false));
    v += __int_as_float(__builtin_amdgcn_update_dpp(0, __float_as_int(v), 0x121, 0xf, 0xf, false));
    return v;
}
__device__ __forceinline__ f32x4 ntld4(const float* p) { return __builtin_nontemporal_load((const f32x4*)p); }
__device__ __forceinline__ void decode_item(const float* __restrict__ Kb, const float* __restrict__ Vb, int ntok, bool newtok, const bf16* qrows, LAS float* scr, float* po, float* pml, int lane) {
    const int hml = lane >> 4, c = lane & 15, row = lane >> 1, half = lane & 1, hl = lane >> 5;
    constexpr float QS = 0.125f * 1.4426950408889634f;
    f32x4 qv[2][4];
#pragma unroll
    for (int v = 0; v < 2; ++v)
#pragma unroll
        for (int tq = 0; tq < 4; ++tq) { const unsigned long long w = *(const GAS unsigned long long*)(qrows + tq * 512 + (4 * v + hml) * 64 + 4 * c);
            qv[v][tq] = (f32x4){bflo((unsigned)w) * QS, bfhi((unsigned)w) * QS, bflo((unsigned)(w >> 32)) * QS, bfhi((unsigned)(w >> 32)) * QS}; }
    f32x4 o[2][4][2];
#pragma unroll
    for (int v = 0; v < 2; ++v)
#pragma unroll
        for (int tq = 0; tq < 4; ++tq) { o[v][tq][0] = (f32x4){0.f, 0.f, 0.f, 0.f}; o[v][tq][1] = (f32x4){0.f, 0.f, 0.f, 0.f}; }
    float m_run = -1e30f, l_run = 0.f;
    const float NEG = -__builtin_inff();
    for (int t0 = 0; t0 < ntok; t0 += 16) {
#pragma unroll 1
        for (int tt = 0; tt < 16; tt += 4) {
            f32x4 kk[4][2];
#pragma unroll
            for (int i = 0; i < 4; ++i)
#pragma unroll
                for (int v = 0; v < 2; ++v) { const int t = t0 + tt + i; kk[i][v] = (t < ntok) ? ntld4(Kb + (size_t)t * 512 + v * 256 + lane * 4) : (f32x4){0.f, 0.f, 0.f, 0.f}; }
#pragma unroll
            for (int i = 0; i < 4; ++i)
#pragma unroll
                for (int v = 0; v < 2; ++v) { const int t = t0 + tt + i; float s[4];
#pragma unroll
                    for (int tq = 0; tq < 4; ++tq) { const f32x4 p = qv[v][tq] * kk[i][v]; s[tq] = row16_sum((p[0] + p[1]) + (p[2] + p[3])); }
                    float sv = (c == 0) ? s[0] : (c == 1) ? s[1] : (c == 2) ? s[2] : s[3];
                    if (t >= ntok || (newtok && t > c)) sv = NEG;
                    if (c < 4) scr[(tt + i) * 32 + (4 * v + hml) * 4 + c] = sv; }
        }
        asm volatile("s_waitcnt lgkmcnt(0)" ::: "memory");
        { float sv[8]; float bm = NEG;
#pragma unroll
            for (int i = 0; i < 8; ++i) { sv[i] = scr[(half * 8 + i) * 32 + row]; bm = fmaxf(bm, sv[i]); }
            bm = fmaxf(bm, __shfl_xor(bm, 1));
            const float mn = fmaxf(m_run, bm), alpha = __builtin_amdgcn_exp2f(m_run - mn); float ps = 0.f;
#pragma unroll
            for (int i = 0; i < 8; ++i) { const float p = __builtin_amdgcn_exp2f(sv[i] - mn); ps += p; scr[(half * 8 + i) * 32 + row] = p; }
            ps += __shfl_xor(ps, 1);
            l_run = l_run * alpha + ps; m_run = mn;
            if (half == 0) scr[512 + row] = alpha; }
        asm volatile("s_waitcnt lgkmcnt(0)" ::: "memory");
#pragma unroll
        for (int v = 0; v < 2; ++v) { const int h = 2 * v + hl; const f32x4 a0 = *(const LAS f32x4*)(scr + 512 + (h * 2 + 0) * 4), a1 = *(const LAS f32x4*)(scr + 512 + (h * 2 + 1) * 4);
#pragma unroll
            for (int tq = 0; tq < 4; ++tq) { o[v][tq][0] = o[v][tq][0] * a0[tq]; o[v][tq][1] = o[v][tq][1] * a1[tq]; } }
#pragma unroll 1
        for (int tt = 0; tt < 16; tt += 4) {
            f32x4 vv[4][2];
#pragma unroll
            for (int i = 0; i < 4; ++i)
#pragma unroll
                for (int v = 0; v < 2; ++v) { const int t = t0 + tt + i; vv[i][v] = (t < ntok) ? ntld4(Vb + (size_t)t * 512 + v * 256 + lane * 4) : (f32x4){0.f, 0.f, 0.f, 0.f}; }
#pragma unroll
            for (int i = 0; i < 4; ++i)
#pragma unroll
                for (int v = 0; v < 2; ++v) { const int h = 2 * v + hl;
                    const f32x4 p0 = *(const LAS f32x4*)(scr + (tt + i) * 32 + (h * 2 + 0) * 4), p1 = *(const LAS f32x4*)(scr + (tt + i) * 32 + (h * 2 + 1) * 4);
#pragma unroll
                    for (int tq = 0; tq < 4; ++tq) { o[v][tq][0] += vv[i][v] * p0[tq]; o[v][tq][1] += vv[i][v] * p1[tq]; } }
        }
        asm volatile("s_waitcnt lgkmcnt(0)" ::: "memory");
    }
    if (half == 0) { pml[row * 2] = m_run; pml[row * 2 + 1] = l_run; }
#pragma unroll
    for (int v = 0; v < 2; ++v)
#pragma unroll
        for (int tq = 0; tq < 4; ++tq)
#pragma unroll
            for (int m = 0; m < 2; ++m) *(f32x4*)(po + (((2 * v + hl) * 2 + m) * 4 + tq) * 128 + 4 * (lane & 31)) = o[v][tq][m];
}

__device__ __forceinline__ void sample_ret_group(Frame& F, int item, const bf16* RQ, const bf16* RK, const bf16* RV, const bf16* RGs, const float* __restrict__ state, float* __restrict__ sout, bf16* CAT) {
    typedef float f32x2 __attribute__((ext_vector_type(2)));
    const int lane = F.lane, w4 = F.wave & 3, grp = F.wave >> 2;
    LAS f32x2* part = (LAS f32x2*)(F.lds + RING_OFF) + grp * (4 * 4 * 64);
    const bool act = item >= 0; const int db = act ? item >> 2 : 0, h = item & 3;
    const int rowb = MP + db * 4; const float lg = log2_gamma(h);
    float qd[4], kd[4]; f32x2 vv[4]; float gp[5];
#pragma unroll
    for (int n = 0; n < 5; ++n) gp[n] = __builtin_amdgcn_exp2f(lg * (float)n);
#pragma unroll
    for (int i = 0; i < 4; ++i) { qd[i] = bf2f(RQ[(size_t)(rowb + i) * 256 + h * 64 + lane]); kd[i] = bf2f(RK[(size_t)(rowb + i) * 256 + h * 64 + lane]);
        const unsigned w = *(const GAS unsigned*)(RV + (size_t)(rowb + i) * 512 + h * 128 + 2 * lane); vv[i] = (f32x2){bflo(w), bfhi(w)}; }
    const float* S = state + ((size_t)(db * 4 + h) * 64 + 16 * w4) * 128; float* SO = sout + ((size_t)(db * 4 + h) * 64 + 16 * w4) * 128;
    f32x2 sr[16];
#pragma unroll
    for (int d = 0; d < 16; ++d) sr[d] = *(const GAS f32x2*)(S + d * 128 + 2 * lane);
    f32x2 cr[4] = {(f32x2){0.f, 0.f}, (f32x2){0.f, 0.f}, (f32x2){0.f, 0.f}, (f32x2){0.f, 0.f}};
#pragma unroll
    for (int d = 0; d < 16; ++d) { f32x2 ns = sr[d] * gp[4];
#pragma unroll
        for (int i = 0; i < 4; ++i) { const float qs = __int_as_float(__builtin_amdgcn_readlane(__float_as_int(qd[i]), 16 * w4 + d)); cr[i] += sr[d] * qs;
            const float ks = __int_as_float(__builtin_amdgcn_readlane(__float_as_int(kd[i]), 16 * w4 + d)) * gp[3 - i]; ns += vv[i] * ks; }
        if (act) *(GAS f32x2*)(SO + d * 128 + 2 * lane) = ns; }
#pragma unroll
    for (int i = 0; i < 4; ++i) part[(w4 * 4 + i) * 64 + lane] = cr[i];
    LDS_WAIT(); __syncthreads();
#pragma unroll
    for (int i = 0; i < 4; ++i) if (i == w4) {
        f32x2 ov = (f32x2){0.f, 0.f};
#pragma unroll
        for (int j = 0; j <= i; ++j) { const float qk = wave_sum(qd[i] * kd[j]) * gp[i - j]; ov += vv[j] * qk; }
        const f32x2 c = part[(0 * 4 + i) * 64 + lane] + part[(1 * 4 + i) * 64 + lane] + part[(2 * 4 + i) * 64 + lane] + part[(3 * 4 + i) * 64 + lane];
        ov += c * gp[i + 1];
        const float ss = wave_sum(ov.x * ov.x + ov.y * ov.y); const float r = 1.f / sqrtf(ss * (1.f / 128.f) + 1e-6f);
        const unsigned g = *(const GAS unsigned*)(RGs + (size_t)(rowb + i) * 512 + h * 128 + 2 * lane);
        if (act) *(GAS unsigned*)(CAT + (size_t)(rowb + i) * 1024 + 512 + h * 128 + 2 * lane) = pk2(ov.x * r * bflo(g), ov.y * r * bfhi(g));
    }
    LDS_WAIT(); __syncthreads();
}

#define PHASE_BEGIN() GAS unsigned char* wsg_ = (GAS unsigned char*)args.ws; { int t_ = threadIdx.x; asm volatile("" : "+v"(t_)); F.tid = t_; F.lane = t_ & 63; F.wave = __builtin_amdgcn_readfirstlane(t_ >> 6); asm volatile("" : "+s"(wsg_)); } \
    unsigned char* wsl = (unsigned char*)wsg_; float* out = (float*)(GAS float*)args.out; const int gw = F.vcu * NWAVES + F.wave, NGW = F.G * NWAVES, gt = F.vcu * (NWAVES * 64) + F.tid, NGT = F.G * NWAVES * 64; (void)out; (void)gw; (void)NGW; (void)gt; (void)NGT
#define AIN(i) ((const float*)(const GAS float*)args.in[i])
#define WSP(type, off) ((type*)(wsl + (off)))
struct Args { const float* in[15]; float* out; unsigned char* ws; };
__global__ void __launch_bounds__(NWAVES * 64, 2) hymba_fwd(Args args) {
    extern __shared__ __attribute__((aligned(16))) unsigned char lds[];
    Frame F;
    F.lds = (LAS unsigned char*)lds;
    F.MISC = (volatile LAS unsigned*)(F.lds + MISC_OFF);
    F.tid = threadIdx.x; F.lane = F.tid & 63; F.wave = __builtin_amdgcn_readfirstlane(F.tid >> 6);
    F.G = gridDim.x; { const int bx = blockIdx.x; F.vcu = (F.G % 8 == 0) ? (bx % 8) * (F.G / 8) + bx / 8 : bx; }
    F.ctl = (gu32*)(args.ws + WS_CTL);
    for (int u = F.tid; u < (LDS_BYTES - LDSCTL_OFF) / 4; u += NWAVES * 64) ((LAS unsigned*)(F.lds + LDSCTL_OFF))[u] = 0u;
    __syncthreads();
    XcdBarrier bar = xcd_barrier_post((unsigned*)(F.ctl + CW_BAR), F.MISC + 8);

#if PH_HI > 0
    {
        PHASE_BEGIN();
        float* cosd = WSP(float, TAB_COSD); float* sind = WSP(float, TAB_SIND); float* cosr = WSP(float, TAB_COSR); float* sinr = WSP(float, TAB_SINR);
        for (int rep = 0; rep < REP_P0; ++rep) {
        for (int e = gt; e < 8192 * 40; e += NGT) { const int pos = e / 40, f = e % 40; float s, c;
            if (f < 8) { sincos_d((double)pos * INV_D[f], s, c); cosd[pos * 8 + f] = c; sind[pos * 8 + f] = s; }
            else { sincos_d((double)pos * INV_R[f - 8], s, c); cosr[pos * 32 + f - 8] = c; sinr[pos * 32 + f - 8] = s; } }
        LAS float* scr = (LAS float*)(F.lds + RING_OFF + F.wave * 16384);
        constexpr int I_IN = (DM / 64) * (NIN / 32), I_OUT = (DM / 64) * (DM / 32), I_UP = (DM / 64) * (NUP / 32), I_DN = (DFF / 64) * (DM / 32);
        for (int it = gw; it < I_IN + I_OUT + I_UP + I_DN; it += NGW) {
            int r = it;
            if (r < I_IN) { p0_transpose_item<1>(AIN(7), DM, NIN, WSP(bf16, WS_WIN), nullptr, scr, r, F.lane); continue; } r -= I_IN;
            if (r < I_OUT) { p0_transpose_item<0>(AIN(10), DM, DM, WSP(bf16, WS_WOUT), nullptr, scr, r, F.lane); continue; } r -= I_OUT;
            if (r < I_UP) { p0_transpose_item<2>(AIN(12), DM, NUP, WSP(bf16, WS_WUP), AIN(11), scr, r, F.lane); continue; } r -= I_UP;
            p0_transpose_item<0>(AIN(13), DFF, DM, WSP(bf16, WS_WDN), nullptr, scr, r, F.lane);
        }
        const float* x_prompt = AIN(0); const float* x_sample = AIN(1); bf16* XN = WSP(bf16, WS_XN);
        for (int m = gw; m < MT; m += 2 * NGW) { const int m2 = m + NGW;
            rms_row2_to_bf16(F.lane, m < MP ? x_prompt + (size_t)m * DM : x_sample + (size_t)(m - MP) * DM, m2 < MP ? x_prompt + (size_t)m2 * DM : x_sample + (size_t)(m2 - MP) * DM, m2 < MT, AIN(6), XN + (size_t)m * DM, XN + (size_t)m2 * DM); }
        }
        xcd_barrier(bar);
    }
#endif
#if PH_HI > 1
    {
        PHASE_BEGIN();
        pg8::Gemm g{WSP(bf16, WS_XN), WSP(bf16, WS_WIN), MP, NIN, DM}; pg8::StaticOrder S; S.init(MP, NIN, F.G, (int)blockIdx.x);
        pg8::EpiInProj E{WSP(bf16, WS_DQ), WSP(bf16, WS_DK), WSP(bf16, WS_DV), WSP(bf16, WS_RQ), WSP(bf16, WS_RK), WSP(bf16, WS_RV), WSP(bf16, WS_RG), out,
                         WSP(float, TAB_COSD), WSP(float, TAB_SIND), WSP(float, TAB_COSR), WSP(float, TAB_SINR)};
        for (int rep = 0; rep < REP_P1; ++rep)
        pg8::gemm_phase<pg8::EpiInProj, pg8::StaticOrder, true, true>(F.lds + RING_OFF, g, S, E);
        pg8::skinny_phase(WSP(bf16, WS_XN) + (size_t)MP * DM, WSP(bf16, WS_WIN), DM, NIN, MP, E, F.vcu, F.G);
        xcd_barrier(bar);
    }
#endif
#if PH_HI > 2
    {
        PHASE_BEGIN();
        for (int rep = 0; rep < REP_P2A; ++rep)
        for (int vv = F.vcu; vv < 256; vv += F.G) {
            const int hm = (vv >> 4) & 15, s = vv & 15, b = hm >> 3, h = (hm >> 1) & 3, m = hm & 1;
            bf16* DQ = WSP(bf16, WS_DQ); bf16* DK = WSP(bf16, WS_DK); bf16* DV = WSP(bf16, WS_DV); bf16* OA = WSP(bf16, WS_OA);
            att::BlockRef r0, r1;
            const size_t rb = (size_t)b * SEQ;
            r0.Q = DQ + (rb + (size_t)s * 256) * 512 + (h * 2 + m) * 64; r0.K = DK + rb * 512 + (h * 2 + m) * 64; r0.V = DV + rb * 512 + h * 128;
            r0.O = OA + (rb + (size_t)s * 256) * 1024 + (h * 2 + m) * 128; r0.P0 = s * 256;
            r1 = r0; r1.Q = DQ + (rb + (size_t)(31 - s) * 256) * 512 + (h * 2 + m) * 64; r1.O = OA + (rb + (size_t)(31 - s) * 256) * 1024 + (h * 2 + m) * 128; r1.P0 = (31 - s) * 256;
            att::Seam S;
            att::attn_prime(r0, (char*)lds + RING_OFF, S);
            att::attn_block(r0, r1, (char*)lds + RING_OFF, S);
            att::attn_block(r1, r1, (char*)lds + RING_OFF, S);
        }
        VM_WAIT(); __syncthreads();
    }
    {
        PHASE_BEGIN();
        LAS float* scr = (LAS float*)(F.lds + RING_OFF) + F.wave * 1024;
        const float* cache_k = AIN(2); const float* cache_v = AIN(3); const int* page_table = (const int*)AIN(5);
        for (int rep = 0; rep < REP_P2B; ++rep)
        for (int it = gw; it < DEC_B * N_ITEMS; it += NGW) {
            int db, pg; if (it < DEC_B * N_PAGES) { db = it >> 4; pg = it & 15; } else { db = it - DEC_B * N_PAGES; pg = N_PAGES; }
            const float* Kb; const float* Vb; int ntok;
            if (pg < N_PAGES) { const int phys = __builtin_amdgcn_readfirstlane(page_table[db * N_PAGES + pg]); Kb = cache_k + (size_t)phys * PAGE * 512; Vb = cache_v + (size_t)phys * PAGE * 512; ntok = PAGE; }
            else { Kb = out + pg8::OFF_KS + (size_t)db * 4 * 512; Vb = out + pg8::OFF_VS + (size_t)db * 4 * 512; ntok = DEC_T; }
            const int item = db * N_ITEMS + pg;
            decode_item(Kb, Vb, ntok, pg == N_PAGES, WSP(bf16, WS_DQ) + (size_t)(MP + db * 4) * 512, scr, WSP(float, WS_DECO) + (size_t)item * 4096, WSP(float, WS_DECML) + (size_t)item * 64, F.lane);
        }
        __syncthreads();
    }
    {
        PHASE_BEGIN();
        for (int rep = 0; rep < REP_P2C; ++rep) {
        for (int u = F.vcu; u < 512; u += F.G) ret_kv_unit(F, u >> 6, u & 63, WSP(bf16, WS_RK), WSP(bf16, WS_RV), WSP(float, WS_KV));
        for (int it0 = 0; it0 < DEC_B * 4; it0 += 2 * F.G) { const int it = it0 + 2 * F.vcu + (F.wave >> 2);
            sample_ret_group(F, it < DEC_B * 4 ? it : -1, WSP(bf16, WS_RQ), WSP(bf16, WS_RK), WSP(bf16, WS_RV), WSP(bf16, WS_RG), AIN(4), out + pg8::OFF_RS, WSP(bf16, WS_CAT)); }
        }
        xcd_barrier(bar);
    }
#endif
#if PH_HI > 3
    {
        PHASE_BEGIN();
        for (int rep = 0; rep < REP_P3; ++rep) {
        { float* KV = WSP(float, WS_KV); bf16* ST = WSP(bf16, WS_ST);
        for (int e = gt; e < 8 * 8192; e += NGT) { const int bh = e >> 13, idx = e & 8191, h = bh & 3; const float gc = __builtin_amdgcn_exp2f(log2_gamma(h) * 128.f);
            float s = 0.f; const float* kv = KV + (size_t)bh * 64 * 8192 + idx; bf16* st = ST + (size_t)bh * 64 * 8192 + idx;
            float kvv[64];
#pragma unroll
            for (int c = 0; c < 64; ++c) kvv[c] = kv[(size_t)c * 8192];
#pragma unroll
            for (int c = 0; c < 64; ++c) { st[(size_t)c * 8192] = (bf16)f2bf(s); s = s * gc + kvv[c]; }
            const int ee = idx >> 6, d = idx & 63; out[pg8::OFF_RP + (size_t)bh * 8192 + d * 128 + ee] = s; } }
        const float* diff_lambda = AIN(8); const float* subln_g = AIN(9);
        bf16* OA = WSP(bf16, WS_OA); bf16* CAT = WSP(bf16, WS_CAT); float* DECO = WSP(float, WS_DECO); float* DECML = WSP(float, WS_DECML);
        float lam;
        { const float a = diff_lambda[F.lane] * diff_lambda[64 + F.lane], bq = diff_lambda[128 + F.lane] * diff_lambda[192 + F.lane];
          lam = __expf(wave_sum(a)) - __expf(wave_sum(bq)) + 0.2f; }
        const int hh = F.lane >> 4, ch = F.lane & 15;
        f32x4 sg0 = *(const f32x4*)(subln_g + ch * 8), sg1 = *(const f32x4*)(subln_g + ch * 8 + 4);
        for (int row = gw; row < MP; row += NGW) {
            const v4u a = *(const GAS v4u*)(OA + (size_t)row * 1024 + (hh * 2) * 128 + ch * 8), bq = *(const GAS v4u*)(OA + (size_t)row * 1024 + (hh * 2 + 1) * 128 + ch * 8);
            float d[8]; const unsigned aw[4] = {a.x, a.y, a.z, a.w}, bw[4] = {bq.x, bq.y, bq.z, bq.w}; float ss = 0.f;
#pragma unroll
            for (int q = 0; q < 4; ++q) { d[2 * q] = bflo(aw[q]) - lam * bflo(bw[q]); d[2 * q + 1] = bfhi(aw[q]) - lam * bfhi(bw[q]); ss += d[2 * q] * d[2 * q] + d[2 * q + 1] * d[2 * q + 1]; }
            ss += __shfl_xor(ss, 1); ss += __shfl_xor(ss, 2); ss += __shfl_xor(ss, 4); ss += __shfl_xor(ss, 8);
            const float r = 0.8f / sqrtf(ss * (1.f / 128.f) + 1e-5f);
            v4u o; o.x = pk2(d[0] * r * sg0[0], d[1] * r * sg0[1]); o.y = pk2(d[2] * r * sg0[2], d[3] * r * sg0[3]); o.z = pk2(d[4] * r * sg1[0], d[5] * r * sg1[1]); o.w = pk2(d[6] * r * sg1[2], d[7] * r * sg1[3]);
            *(GAS v4u*)(CAT + (size_t)row * 1024 + hh * 128 + ch * 8) = o;
        }
        for (int it = gw; it < MS * 4; it += NGW) {
            typedef float f32x2 __attribute__((ext_vector_type(2)));
            const int srow = it >> 2, h = it & 3, db = srow >> 2, tq = srow & 3; f32x2 om[2];
#pragma unroll
            for (int m = 0; m < 2; ++m) { const int r = (h * 2 + m) * 4 + tq; float M = -1e30f;
                for (int pgi = 0; pgi < N_ITEMS; ++pgi) M = fmaxf(M, DECML[(size_t)(db * N_ITEMS + pgi) * 64 + r * 2]);
                float L = 0.f; f32x2 acc = (f32x2){0.f, 0.f};
                for (int pgi = 0; pgi < N_ITEMS; ++pgi) { const size_t item = (size_t)(db * N_ITEMS + pgi); const float w = __builtin_amdgcn_exp2f(DECML[item * 64 + r * 2] - M);
                    L += w * DECML[item * 64 + r * 2 + 1]; acc += *(const f32x2*)(DECO + item * 4096 + r * 128 + 2 * F.lane) * w; }
                om[m] = acc * (1.f / L); }
            const f32x2 dd = om[0] - om[1] * lam;
            const float ss = wave_sum(dd.x * dd.x + dd.y * dd.y); const float r = 0.8f / sqrtf(ss * (1.f / 128.f) + 1e-5f);
            *(GAS unsigned*)(CAT + (size_t)(MP + srow) * 1024 + h * 128 + 2 * F.lane) = pk2(dd.x * r * subln_g[2 * F.lane], dd.y * r * subln_g[2 * F.lane + 1]);
        }
        }
        xcd_barrier(bar);
    }
#endif
#if PH_HI > 4
    {
        PHASE_BEGIN();
        for (int rep = 0; rep < REP_P4; ++rep)
        for (int u = F.vcu; u < 512; u += F.G) ret_out_unit(F, u >> 6, u & 63, WSP(bf16, WS_RQ), WSP(bf16, WS_RK), WSP(bf16, WS_RV), WSP(bf16, WS_RG), WSP(bf16, WS_ST), WSP(bf16, WS_CAT));
        xcd_barrier(bar);
    }
#endif
#if PH_HI > 5
    {
        PHASE_BEGIN();
        pg8::Gemm g{WSP(bf16, WS_CAT), WSP(bf16, WS_WOUT), MP, DM, DM}; pg8::StaticOrder S; S.init(MP, DM, F.G, (int)blockIdx.x);
        pg8::EpiOutProj E{AIN(0), AIN(1), WSP(bf16, WS_X1B), WSP(float, WS_SSQ)};
        for (int rep = 0; rep < REP_P5; ++rep)
        pg8::gemm_phase<pg8::EpiOutProj, pg8::StaticOrder, true, true>(F.lds + RING_OFF, g, S, E);
        pg8::skinny_phase(WSP(bf16, WS_CAT) + (size_t)MP * DM, WSP(bf16, WS_WOUT), DM, DM, MP, E, F.vcu, F.G);
        xcd_barrier(bar);
    }
#endif
#if PH_HI > 6
    {
        PHASE_BEGIN();
        pg8::Gemm g{WSP(bf16, WS_X1B), WSP(bf16, WS_WUP), MT, NUP, DM}; pg8::StaticOrder S; S.init(MT, NUP, F.G, (int)blockIdx.x);
        pg8::EpiUp E{WSP(bf16, WS_H), WSP(float, WS_SSQ)};
        for (int rep = 0; rep < REP_P6; ++rep)
        pg8::gemm_phase<pg8::EpiUp, pg8::StaticOrder, true, true>(F.lds + RING_OFF, g, S, E);
        xcd_barrier(bar);
    }
#endif
#if PH_HI > 7
    {
        PHASE_BEGIN();
        pg8::Gemm g{WSP(bf16, WS_H), WSP(bf16, WS_WDN), MP, DM, DFF}; pg8::StaticOrder S; S.init(MP, DM, F.G, (int)blockIdx.x);
        pg8::EpiDown E{WSP(bf16, WS_X1B), out + pg8::OFF_Y};
        for (int rep = 0; rep < REP_P7; ++rep)
        pg8::gemm_phase<pg8::EpiDown, pg8::StaticOrder, true, true>(F.lds + RING_OFF, g, S, E);
        pg8::skinny_phase(WSP(bf16, WS_H) + (size_t)MP * DFF, WSP(bf16, WS_WDN), DFF, DM, MP, E, F.vcu, F.G);
        xcd_barrier(bar);
    }
#endif
#if PH_HI > 8
    {
        PHASE_BEGIN();
        const float* norm_final_g = AIN(14);
        for (int m = gw; m < MT; m += NGW) { float* yr = out + pg8::OFF_Y + (size_t)m * DM;
            GAS f32x4* xr = (GAS f32x4*)yr + F.lane; const GAS f32x4* gr = (const GAS f32x4*)norm_final_g + F.lane;
            f32x4 v[4]; float s = 0.f;
#pragma unroll
            for (int j = 0; j < 4; ++j) { v[j] = xr[64 * j]; s += (v[j].x * v[j].x + v[j].y * v[j].y) + (v[j].z * v[j].z + v[j].w * v[j].w); }
            const float r = 1.f / sqrtf(wave_sum(s) * (1.f / DM) + 1e-6f);
#pragma unroll
            for (int j = 0; j < 4; ++j) xr[64 * j] = v[j] * r * gr[64 * j]; }
        for (int rep = 0; rep < REP_BAR; ++rep) xcd_barrier(bar);
    }
#endif
}

extern "C" void kernel_launch(void* const* d_in, const int* in_sizes, int n_in, void* d_out, int out_size, void* d_ws, size_t ws_size, hipStream_t stream) {
    static int grid = 0;
    if (grid == 0) {
        if (n_in != 15 || ws_size < WS_END) { fprintf(stderr, "kernel_launch: unexpected inputs (n_in %d, ws %zu)\n", n_in, ws_size); grid = -1; return; }
        int dev = 0, cus = 0, per_cu = 0;
        if (hipGetDevice(&dev) != hipSuccess || hipDeviceGetAttribute(&cus, hipDeviceAttributeMultiprocessorCount, dev) != hipSuccess) { grid = -1; return; }
        if (hipFuncSetAttribute((const void*)hymba_fwd, hipFuncAttributeMaxDynamicSharedMemorySize, LDS_BYTES) != hipSuccess) { fprintf(stderr, "kernel_launch: hipFuncSetAttribute failed\n"); grid = -1; return; }
        if (hipOccupancyMaxActiveBlocksPerMultiprocessor(&per_cu, (const void*)hymba_fwd, NWAVES * 64, LDS_BYTES) != hipSuccess || per_cu < 1) fprintf(stderr, "kernel_launch: occupancy query reports %d\n", per_cu);
        (void)hipGetLastError();
        grid = cus;
    }
    if (grid < 0) return;
    if (hipMemsetAsync((char*)d_ws + WS_CTL, 0, CTL_ZERO_BYTES, stream) != hipSuccess) return;
    Args a{};
    for (int i = 0; i < 15; ++i) a.in[i] = (const float*)d_in[i];
    a.out = (float*)d_out; a.ws = (unsigned char*)d_ws;
    hipLaunchKernelGGL(hymba_fwd, dim3(grid), dim3(NWAVES * 64), LDS_BYTES, stream, a);
}
```
